# Optimizing an MI355X kernel written in HIP

```python
import math
import jax, jax.numpy as jnp
from jax import lax
import numpy as np

D_MODEL = 2048
BATCH = 8
SEQ = 4096
DEPTH = 2

GRID_W = 64
CTX_LEN = 256
D_POOL = D_MODEL // 2
D_ATTN = D_MODEL // 2
D_MIX = D_POOL + D_ATTN
POOL_WINDOWS = (2, 4, 8, 16)
N_POOL_GROUPS = len(POOL_WINDOWS)
POOL_GROUP = D_POOL // N_POOL_GROUPS
DIFF_HEAD_DIM = 64
N_DIFF_HEADS = D_ATTN // (2 * DIFF_HEAD_DIM)
V_HEAD_DIM = 2 * DIFF_HEAD_DIM
ROPE_PAIRS = DIFF_HEAD_DIM // 4
ROPE_BASE = 10000.0
Q_BLOCK = 128
EPS = 1e-6
O_POOL_V = 0
O_POOL_G = O_POOL_V + D_POOL
O_Q = O_POOL_G + D_POOL
O_K = O_Q + D_ATTN
O_V = O_K + D_ATTN
O_ATTN_G = O_V + D_ATTN
D_IN = O_ATTN_G + D_ATTN

kernel_name = 'hybrid_pool_diffattn_prefix_block'


def rms_norm(x, w):
    xf = x.astype(jnp.float32)
    y = xf * lax.rsqrt(jnp.mean(xf * xf, axis=-1, keepdims=True) + EPS)
    return (y * w.astype(jnp.float32)).astype(x.dtype)


def adaln_params(cond, w_ada, b_ada):
    mod = jax.nn.silu(cond) @ w_ada + b_ada
    shift, scale, gate = jnp.split(mod, 3, axis=-1)
    return shift[:, None, :], scale[:, None, :], gate[:, None, :]


def multiscale_pool(v, pool_w, pool_scale):
    B, L, _ = v.shape
    vf = v.astype(jnp.float32)
    csum = jnp.concatenate([jnp.zeros((B, 1, D_POOL), jnp.float32), jnp.cumsum(vf, axis=1)], axis=1)
    t = jnp.arange(L)
    outs = []
    for g, w in enumerate(POOL_WINDOWS):
        sl = slice(g * POOL_GROUP, (g + 1) * POOL_GROUP)
        lo = jnp.clip(t - w // 2, 0, L)
        hi = jnp.clip(t + w // 2, 0, L)
        cs = csum[:, :, sl]
        cnt = (hi - lo).astype(jnp.float32)[None, :, None]
        mean = (jnp.take(cs, hi, axis=1) - jnp.take(cs, lo, axis=1)) / cnt
        outs.append(mean - vf[:, :, sl])
    pooled = jnp.stack(outs, axis=2)
    mixed = jnp.einsum('blgc,gcd->blgd', pooled, pool_w.astype(jnp.float32))
    return (mixed.reshape(B, L, D_POOL) * pool_scale.astype(jnp.float32)).astype(v.dtype)


def axial_rope_tables(L, dtype):
    rows = L // GRID_W
    row = jnp.broadcast_to(jnp.arange(rows)[:, None], (rows, GRID_W)).reshape(-1).astype(jnp.float32)
    col = jnp.broadcast_to(jnp.arange(GRID_W)[None, :], (rows, GRID_W)).reshape(-1).astype(jnp.float32)
    inv_freq = ROPE_BASE ** (-jnp.arange(ROPE_PAIRS, dtype=jnp.float32) / ROPE_PAIRS)
    ang_r = row[:, None] * inv_freq
    ang_c = col[:, None] * inv_freq
    shape = (1, L, 1, 1, ROPE_PAIRS)
    cos_r = jnp.cos(ang_r).reshape(shape).astype(dtype)
    sin_r = jnp.sin(ang_r).reshape(shape).astype(dtype)
    cos_c = jnp.cos(ang_c).reshape(shape).astype(dtype)
    sin_c = jnp.sin(ang_c).reshape(shape).astype(dtype)
    return (cos_r, sin_r, cos_c, sin_c)


def rotate_half(x, cos, sin):
    x1, x2 = jnp.split(x, 2, axis=-1)
    return jnp.concatenate([x1 * cos - x2 * sin, x2 * cos + x1 * sin], axis=-1)


def apply_axial_rope(x, tables):
    cos_r, sin_r, cos_c, sin_c = tables
    half = DIFF_HEAD_DIM // 2
    return jnp.concatenate([rotate_half(x[..., :half], cos_r, sin_r),
                            rotate_half(x[..., half:], cos_c, sin_c)], axis=-1)


def diff_attend(q, k, v, lam):
    s = jnp.einsum('bqhnd,bkhnd->bhnqk', q, k).astype(jnp.float32) * (DIFF_HEAD_DIM ** -0.5)
    p = jax.nn.softmax(s, axis=-1)
    a = p[:, :, 0] - lam * p[:, :, 1]
    return jnp.einsum('bhqk,bkhe->bqhe', a.astype(v.dtype), v)


def merge_branches(p, o_attn, lam_init, pool_w, pool_scale, subln_w, w_out):
    B, L = p.shape[:2]
    pool_o = multiscale_pool(p[..., O_POOL_V:O_POOL_G], pool_w, pool_scale) * jax.nn.silu(p[..., O_POOL_G:O_Q])
    attn_o = (rms_norm(o_attn, subln_w).reshape(B, L, D_ATTN) * (1.0 - lam_init)
              * jax.nn.silu(p[..., O_ATTN_G:D_IN]))
    return jnp.concatenate([pool_o, attn_o], axis=-1) @ w_out


def hybrid_layer(x, ctx, c, c_ctx, rope_tables, layer_idx, update_ctx,
                 norm_w, w_ada, b_ada, w_in, pool_w, pool_scale, q_norm_w, k_norm_w,
                 lambda_q1, lambda_k1, lambda_q2, lambda_k2, subln_w, w_out):
    B, L, _ = x.shape
    C = ctx.shape[1]
    f32 = jnp.float32
    lam_init = 0.8 - 0.6 * math.exp(-0.3 * layer_idx)
    lam = (jnp.exp(jnp.sum(lambda_q1.astype(f32) * lambda_k1.astype(f32)))
           - jnp.exp(jnp.sum(lambda_q2.astype(f32) * lambda_k2.astype(f32))) + lam_init)

    shift, scale, gate = adaln_params(c, w_ada, b_ada)
    shift_c, scale_c, gate_c = adaln_params(c_ctx[None, :], w_ada, b_ada)
    h = rms_norm(x, norm_w) * (1 + scale) + shift
    hc = rms_norm(ctx, norm_w) * (1 + scale_c) + shift_c

    ctx_cols = slice(0, D_IN) if update_ctx else slice(O_K, O_ATTN_G)
    base = ctx_cols.start
    pc = hc @ w_in[:, ctx_cols]
    kc = rms_norm(pc[..., O_K - base:O_V - base].reshape(B, C, N_DIFF_HEADS, 2, DIFF_HEAD_DIM), k_norm_w)
    vc = pc[..., O_V - base:O_ATTN_G - base].reshape(B, C, N_DIFF_HEADS, V_HEAD_DIM)

    p = h @ w_in
    q = apply_axial_rope(rms_norm(p[..., O_Q:O_K].reshape(B, L, N_DIFF_HEADS, 2, DIFF_HEAD_DIM), q_norm_w), rope_tables)
    k = apply_axial_rope(rms_norm(p[..., O_K:O_V].reshape(B, L, N_DIFF_HEADS, 2, DIFF_HEAD_DIM), k_norm_w), rope_tables)
    v = p[..., O_V:O_ATTN_G].reshape(B, L, N_DIFF_HEADS, V_HEAD_DIM)
    k_all = jnp.concatenate([kc, k], axis=1)
    v_all = jnp.concatenate([vc, v], axis=1)
    nb = L // Q_BLOCK
    qb = q.reshape(B, nb, Q_BLOCK, N_DIFF_HEADS, 2, DIFF_HEAD_DIM).swapaxes(0, 1)
    o = lax.map(lambda qi: diff_attend(qi, k_all, v_all, lam), qb)
    o = o.swapaxes(0, 1).reshape(B, L, N_DIFF_HEADS, V_HEAD_DIM)
    x_new = x + gate * merge_branches(p, o, lam_init, pool_w, pool_scale, subln_w, w_out)

    if update_ctx:
        qc = rms_norm(pc[..., O_Q:O_K].reshape(B, C, N_DIFF_HEADS, 2, DIFF_HEAD_DIM), q_norm_w)
        oc = diff_attend(qc, kc, vc, lam)
        ctx_new = ctx + gate_c * merge_branches(pc, oc, lam_init, pool_w, pool_scale, subln_w, w_out)
    else:
        ctx_new = ctx
    return x_new, ctx_new


def setup_inputs(seed: int = 0) -> dict:
    key = jax.random.key(seed)
    ks = jax.random.split(key, 18)
    f32 = jnp.float32

    def nrm(k, shape, s):
        return jax.random.normal(k, shape, f32) * s

    def gain(k, shape):
        return 1.0 + 0.02 * jax.random.normal(k, shape, f32)

    return {
        'x': nrm(ks[0], (BATCH, SEQ, D_MODEL), 1.0),
        'c': nrm(ks[1], (BATCH, D_MODEL), 1.0),
        'ctx': nrm(ks[2], (BATCH, CTX_LEN, D_MODEL), 1.0),
        'c_ctx': nrm(ks[3], (D_MODEL,), 1.0),
        'norm_w': gain(ks[4], (DEPTH, D_MODEL)),
        'w_ada': nrm(ks[5], (DEPTH, D_MODEL, 3 * D_MODEL), D_MODEL ** -0.5),
        'b_ada': nrm(ks[6], (DEPTH, 3 * D_MODEL), 0.02),
        'w_in': nrm(ks[7], (DEPTH, D_MODEL, D_IN), D_MODEL ** -0.5),
        'pool_w': nrm(ks[8], (DEPTH, N_POOL_GROUPS, POOL_GROUP, POOL_GROUP), POOL_GROUP ** -0.5),
        'pool_scale': gain(ks[9], (DEPTH, D_POOL)),
        'q_norm_w': gain(ks[10], (DEPTH, DIFF_HEAD_DIM)),
        'k_norm_w': gain(ks[11], (DEPTH, DIFF_HEAD_DIM)),
        'lambda_q1': nrm(ks[12], (DEPTH, DIFF_HEAD_DIM), 0.1),
        'lambda_k1': nrm(ks[13], (DEPTH, DIFF_HEAD_DIM), 0.1),
        'lambda_q2': nrm(ks[14], (DEPTH, DIFF_HEAD_DIM), 0.1),
        'lambda_k2': nrm(ks[15], (DEPTH, DIFF_HEAD_DIM), 0.1),
        'subln_w': gain(ks[16], (DEPTH, V_HEAD_DIM)),
        'w_out': nrm(ks[17], (DEPTH, D_MIX, D_MODEL), D_MIX ** -0.5),
    }


def reference(x, c, ctx, c_ctx, norm_w, w_ada, b_ada, w_in, pool_w, pool_scale,
              q_norm_w, k_norm_w, lambda_q1, lambda_k1, lambda_q2, lambda_k2, subln_w, w_out):
    rope_tables = axial_rope_tables(x.shape[1], x.dtype)
    for l in range(DEPTH):
        x, ctx = hybrid_layer(x, ctx, c, c_ctx, rope_tables, l, l < DEPTH - 1,
                              norm_w[l], w_ada[l], b_ada[l], w_in[l], pool_w[l], pool_scale[l],
                              q_norm_w[l], k_norm_w[l], lambda_q1[l], lambda_k1[l],
                              lambda_q2[l], lambda_k2[l], subln_w[l], w_out[l])
    return x
```

```cpp
#include <hip/hip_runtime.h>
#include <hip/hip_cooperative_groups.h>
#include <cstdio>
#include <cstdint>
namespace cg = cooperative_groups;

#define LAS __attribute__((address_space(3)))
#define DI __device__ __forceinline__
typedef unsigned short bf16_t;
typedef short bf16x8 __attribute__((ext_vector_type(8)));
typedef short s16x4 __attribute__((ext_vector_type(4)));
typedef float f32x2 __attribute__((ext_vector_type(2)));
typedef float f32x4 __attribute__((ext_vector_type(4)));
typedef float f32x16 __attribute__((ext_vector_type(16)));
typedef unsigned u32x2 __attribute__((ext_vector_type(2)));
typedef unsigned u32x4 __attribute__((ext_vector_type(4)));
typedef __bf16 bf16x2_t __attribute__((ext_vector_type(2)));

constexpr int NB = 8, SEQ = 4096, DM = 2048, CTX = 256, DIN = 6144, NHEAD = 8;
constexpr int ML = NB * SEQ, MC = NB * CTX, MT = ML + MC;
constexpr int O_PV = 0, O_PG = 1024, O_Q = 2048, O_K = 3072, O_V = 4096, O_AG = 5120;
constexpr float EPS = 1e-6f;
constexpr float QSCALE = 0.125f * 1.4426950408889634f;

constexpr size_t MiB = 1u << 20;
constexpr size_t WS_WTIN = 0;
constexpr size_t WS_WTOUT = 48 * MiB;
constexpr size_t WS_WV = 64 * MiB;
constexpr size_t WS_PWT = 72 * MiB;
constexpr size_t WS_MOD = 73 * MiB;
constexpr size_t WS_ROPE = 74 * MiB;
constexpr size_t WS_CTL = 75 * MiB;
constexpr size_t WS_H = 76 * MiB;
constexpr size_t WS_P = 212 * MiB;
constexpr size_t WS_X1 = 620 * MiB;
constexpr size_t WS_C1 = 876 * MiB;
constexpr size_t WS_END = 892 * MiB;

#ifndef REP_P0
#define REP_P0 1
#endif
#ifndef REP_P1
#define REP_P1 1
#endif
#ifndef REP_P2
#define REP_P2 1
#endif
#ifndef REP_P3A
#define REP_P3A 1
#endif
#ifndef REP_P3B
#define REP_P3B 1
#endif
#ifndef REP_P4
#define REP_P4 1
#endif
constexpr int NTHREADS = 512;
constexpr int LDS_BYTES = 147456;

struct Args { const float* in[18]; float* out; unsigned char* ws; };

DI unsigned cvtpk(float lo, float hi) { f32x2 v = {lo, hi}; bf16x2_t b = __builtin_convertvector(v, bf16x2_t); return __builtin_bit_cast(unsigned, b); }
DI float bf_lo(unsigned u) { return __builtin_bit_cast(float, u << 16); }
DI float bf_hi(unsigned u) { return __builtin_bit_cast(float, u & 0xffff0000u); }
template <int K> DI float swz_xor_t(float v) { return __builtin_bit_cast(float, __builtin_amdgcn_ds_swizzle(__builtin_bit_cast(int, v), (K << 10) | 0x1f)); }
#define swz_xor(v, k) swz_xor_t<(k)>(v)
DI float sum_x32(float v) { const unsigned u = __builtin_bit_cast(unsigned, v); auto rr = __builtin_amdgcn_permlane32_swap(u, u, false, false);
    return __builtin_bit_cast(float, (unsigned)rr[0]) + __builtin_bit_cast(float, (unsigned)rr[1]); }
DI float max_x32(float v) { const unsigned u = __builtin_bit_cast(unsigned, v); auto rr = __builtin_amdgcn_permlane32_swap(u, u, false, false);
    return fmaxf(__builtin_bit_cast(float, (unsigned)rr[0]), __builtin_bit_cast(float, (unsigned)rr[1])); }
DI float wave_sum(float v) { v += swz_xor(v, 1); v += swz_xor(v, 2); v += swz_xor(v, 4); v += swz_xor(v, 8); v += swz_xor(v, 16); return sum_x32(v); }
DI float wave_max(float v) { v = fmaxf(v, swz_xor(v, 1)); v = fmaxf(v, swz_xor(v, 2)); v = fmaxf(v, swz_xor(v, 4)); v = fmaxf(v, swz_xor(v, 8)); v = fmaxf(v, swz_xor(v, 16)); return max_x32(v); }
DI float silu_f(float v) { return v * __builtin_amdgcn_rcpf(1.0f + __expf(-v)); }

namespace pg8 {
constexpr int BM = 256, BK = 64, HALF = 128, HTB = HALF * BK * 2, STAGE_BYTES = 8 * HTB, NXCD = 8, WGM = 8;
DI int lds_byte(int r, int c) { const int st = (r >> 4) * 2 + (c >> 5), rr = r & 15, cc = c & 31, ob = rr * 64 + cc * 2; return st * 1024 + (ob ^ (((ob >> 9) & 1) << 5)); }
DI void stage_rc(int b, int& R, int& C) { const int st = b / 1024, sb = b % 1024, swz = sb ^ (((sb >> 9) & 1) << 5); R = (st >> 1) * 16 + swz / 64; C = (st & 1) * 32 + (swz % 64) / 2; }

struct Unit { int pm, pn; };
struct Gemm { int lda, ldb, K; };

struct GridOrder {
    const char* A; const char* Bt; size_t tstepA, tstepB;
    int nM, nN, nwg, G, c;
    int ex_n, ex_pm0, ex_npm, ex_pn0;
    DI void init(const void* A_, const void* Bt_, int lda, int ldb, int nM_, int nN_, int G_, int c_, int ex_n_ = 0, int ex_pm0_ = 0, int ex_npm_ = 1, int ex_pn0_ = 0) {
        A = (const char*)A_; Bt = (const char*)Bt_; tstepA = (size_t)BM * lda * 2; tstepB = (size_t)BM * ldb * 2;
        nM = nM_; nN = nN_; nwg = nM * nN; G = G_; c = c_; ex_n = ex_n_; ex_pm0 = ex_pm0_; ex_npm = ex_npm_; ex_pn0 = ex_pn0_;
    }
    DI bool next(int i, Unit& u) const {
        const long L = (long)i * G + c;
        if (L >= nwg) { const int e = (int)(L - nwg); if (e >= ex_n) return false; u.pm = ex_pm0 + e % ex_npm; u.pn = ex_pn0 + e / ex_npm; return true; }
        int wgid = (int)L; { const int q = nwg / NXCD, r = nwg % NXCD, xcd = wgid % NXCD, off = wgid / NXCD; wgid = (xcd < r ? xcd * (q + 1) : r * (q + 1) + (xcd - r) * q) + off; }
        const int nig = WGM * nN, gid = wgid / nig, fm = gid * WGM, gsz = (nM - fm) < WGM ? (nM - fm) : WGM;
        u.pm = fm + ((wgid % nig) % gsz); u.pn = (wgid % nig) / gsz; return true;
    }
    DI const char* aptr(const Unit& u) const { return A + (size_t)u.pm * tstepA; }
    DI const char* bptr(const Unit& u) const { return Bt + (size_t)u.pn * tstepB; }
};

template <class Epi, class Sched>
DI void gemm_phase(LAS unsigned char* lds, const Gemm g, const Sched& S, const Epi& E) {
    int tid = threadIdx.x; asm volatile("" : "+v"(tid));
    const int wid = __builtin_amdgcn_readfirstlane(tid >> 6), lane = tid & 63, wr = wid >> 2, wc = wid & 3, fr = lane & 15, fq = lane >> 4;
    const int K = g.K, nt = K / BK;
    unsigned voffA[2], voffB[2];
#pragma unroll
    for (int i = 0; i < 2; ++i) { int R, C; stage_rc(tid * 16 + i * 8192, R, C); voffA[i] = (unsigned)(R * g.lda + C) * 2u; voffB[i] = (unsigned)(R * g.ldb + C) * 2u; }
    const size_t kstep = (size_t)(BK * 2);
    const size_t hstepA = (size_t)HALF * g.lda * 2, hstepB = (size_t)HALF * g.ldb * 2;
    const unsigned ldsw = (unsigned)wid * 1024u;
    const int aoff = lds_byte(wr * 64 + fr, fq * 8), boff = lds_byte(wc * 32 + fr, fq * 8);
#define PG8_SA(b, h) (((b) * 2 + (h)) * HTB)
#define PG8_SB(b, h) ((4 + (b) * 2 + (h)) * HTB)
#define PG8_STAGE(bufoff, gbase, voff) do { _Pragma("unroll") for (int _i = 0; _i < 2; ++_i) \
        __builtin_amdgcn_global_load_lds((const unsigned*)((const char*)(gbase) + (voff)[_i]), (LAS unsigned*)(lds + (bufoff) + ldsw + _i * 8192), 16, 0, 0); } while (0)
#define PG8_LDA(dst, b, h) do { _Pragma("unroll") for (int m = 0; m < 4; ++m) _Pragma("unroll") for (int k = 0; k < 2; ++k) dst[m][k] = *(const LAS bf16x8*)(lds + PG8_SA(b, h) + aoff + m * 2048 + k * 1024); } while (0)
#define PG8_LDB(dst, b, h) do { _Pragma("unroll") for (int n = 0; n < 2; ++n) _Pragma("unroll") for (int k = 0; k < 2; ++k) dst[n][k] = *(const LAS bf16x8*)(lds + PG8_SB(b, h) + boff + n * 2048 + k * 1024); } while (0)
#define PG8_MMA(ai, bj, At, Bt) do { __builtin_amdgcn_s_setprio(1); _Pragma("unroll") for (int m = 0; m < 4; ++m) _Pragma("unroll") for (int n = 0; n < 2; ++n) _Pragma("unroll") for (int k = 0; k < 2; ++k) \
        acc[ai][bj][m][n] = __builtin_amdgcn_mfma_f32_16x16x32_bf16(Bt[n][k], At[m][k], acc[ai][bj][m][n], 0, 0, 0); __builtin_amdgcn_s_setprio(0); } while (0)
#define PG8_WAIT_V(n) asm volatile("s_waitcnt vmcnt(" #n ")" ::: "memory")
#define PG8_WAIT_L(n) asm volatile("s_waitcnt lgkmcnt(" #n ")" ::: "memory")
#define PG8_BAR __builtin_amdgcn_s_barrier()
#define PG8_SCHED __builtin_amdgcn_sched_barrier(0)
    Unit cur, nxt; int ui = 0;
    if (!S.next(0, cur)) return;
    f32x4 acc[2][2][4][2];
#pragma unroll
    for (int a = 0; a < 2; ++a)
#pragma unroll
        for (int b = 0; b < 2; ++b)
#pragma unroll
            for (int m = 0; m < 4; ++m)
#pragma unroll
                for (int n = 0; n < 2; ++n) acc[a][b][m][n] = (f32x4){0.f, 0.f, 0.f, 0.f};
    bf16x8 At[4][2], B0[2][2], B1[2][2];
    const char* cA = S.aptr(cur); const char* cB = S.bptr(cur);
    PG8_STAGE(PG8_SB(0, 0), cB, voffB); PG8_STAGE(PG8_SB(0, 1), cB + hstepB, voffB); PG8_STAGE(PG8_SA(0, 0), cA, voffA); PG8_STAGE(PG8_SA(0, 1), cA + hstepA, voffA);
    if (wr == 1) PG8_BAR;
    PG8_WAIT_V(2); PG8_BAR;
    PG8_STAGE(PG8_SB(1, 0), cB + kstep, voffB); PG8_STAGE(PG8_SA(1, 0), cA + kstep, voffA); PG8_STAGE(PG8_SB(1, 1), cB + hstepB + kstep, voffB);
    PG8_WAIT_V(6); PG8_BAR;
    for (;;) {
        const bool has_next = S.next(ui + 1, nxt);
        const char* nA = has_next ? S.aptr(nxt) : cA; const char* nB = has_next ? S.bptr(nxt) : cB;
        for (int t = 0; t < nt; t += 2) {
            const bool last = (t == nt - 2);
            const char* a1 = cA + (size_t)(t + 1) * kstep;
            const char* a2 = last ? nA : cA + (size_t)(t + 2) * kstep; const char* b2 = last ? nB : cB + (size_t)(t + 2) * kstep;
            const char* a3 = a2 + kstep; const char* b3 = b2 + kstep;
            PG8_LDB(B0, 0, 0); PG8_LDB(B1, 0, 1); PG8_SCHED; PG8_LDA(At, 0, 0); PG8_STAGE(PG8_SA(1, 1), a1 + hstepA, voffA);
            PG8_WAIT_V(8); PG8_WAIT_L(0); PG8_BAR; PG8_MMA(0, 0, At, B0); PG8_MMA(0, 1, At, B1); PG8_BAR; PG8_SCHED;
            PG8_LDA(At, 0, 1); PG8_STAGE(PG8_SB(0, 0), b2, voffB); PG8_STAGE(PG8_SB(0, 1), b2 + hstepB, voffB); PG8_STAGE(PG8_SA(0, 0), a2, voffA);
            PG8_WAIT_V(8); PG8_WAIT_L(0); PG8_BAR; PG8_MMA(1, 0, At, B0); PG8_MMA(1, 1, At, B1); PG8_BAR; PG8_SCHED;
            PG8_LDB(B0, 1, 0); PG8_LDB(B1, 1, 1); PG8_SCHED; PG8_LDA(At, 1, 0); PG8_STAGE(PG8_SA(0, 1), a2 + hstepA, voffA);
            PG8_WAIT_V(8); PG8_WAIT_L(0); PG8_BAR; PG8_MMA(0, 0, At, B0); PG8_MMA(0, 1, At, B1); PG8_BAR; PG8_SCHED;
            PG8_LDA(At, 1, 1); PG8_STAGE(PG8_SB(1, 0), b3, voffB); PG8_STAGE(PG8_SB(1, 1), b3 + hstepB, voffB); PG8_STAGE(PG8_SA(1, 0), a3, voffA);
            PG8_WAIT_V(8); PG8_WAIT_L(0); PG8_BAR; PG8_MMA(1, 0, At, B0); PG8_MMA(1, 1, At, B1); PG8_BAR; PG8_SCHED;
        }
        E(acc, cur, wr, wc, fr, fq);
        if (!has_next) break;
#pragma unroll
        for (int a = 0; a < 2; ++a)
#pragma unroll
            for (int b = 0; b < 2; ++b)
#pragma unroll
                for (int m = 0; m < 4; ++m)
#pragma unroll
                    for (int n = 0; n < 2; ++n) acc[a][b][m][n] = (f32x4){0.f, 0.f, 0.f, 0.f};
        cur = nxt; cA = nA; cB = nB; ++ui;
    }
    PG8_WAIT_V(0);
    if (wr == 0) PG8_BAR;
    PG8_BAR;
#undef PG8_SA
#undef PG8_SB
#undef PG8_STAGE
#undef PG8_LDA
#undef PG8_LDB
#undef PG8_MMA
#undef PG8_WAIT_V
#undef PG8_WAIT_L
#undef PG8_BAR
#undef PG8_SCHED
}
}

struct EpiIn {
    bf16_t* P; const float* qw; const float* kw; const float* rope;
    DI void operator()(const f32x4 (&acc)[2][2][4][2], const pg8::Unit& u, int wr, int wc, int fr, int fq) const {
        const int type = u.pn >> 2;
        const int dlo = 32 * (fq >> 1) + 8 * (fq & 1);
        const int colw = u.pn * 256 + 64 * wc + dlo;
        const bool is_ctx = u.pm >= 128;
        if (type == 2 || type == 3) {
            const float* nw = (type == 2) ? qw : kw;
            const float qs = (type == 2) ? QSCALE : 1.0f;
            f32x4 w[2][2];
#pragma unroll
            for (int bj = 0; bj < 2; ++bj)
#pragma unroll
                for (int n = 0; n < 2; ++n) w[bj][n] = *(const f32x4*)(nw + dlo + 16 * bj + 4 * n);
#pragma unroll
            for (int ai = 0; ai < 2; ++ai)
#pragma unroll
                for (int m = 0; m < 4; ++m) {
                    const int row = u.pm * 256 + ai * 128 + wr * 64 + m * 16 + fr;
                    f32x4 v[2][2]; float ss = 0.f;
#pragma unroll
                    for (int bj = 0; bj < 2; ++bj)
#pragma unroll
                        for (int n = 0; n < 2; ++n) { v[bj][n] = acc[ai][bj][m][n]; const f32x4 q = v[bj][n] * v[bj][n]; ss += (q[0] + q[1]) + (q[2] + q[3]); }
                    ss += swz_xor(ss, 16); ss = sum_x32(ss);
                    const float rinv = rsqrtf(ss * (1.0f / 64.0f) + EPS) * qs;
#pragma unroll
                    for (int bj = 0; bj < 2; ++bj)
#pragma unroll
                        for (int n = 0; n < 2; ++n) v[bj][n] = v[bj][n] * rinv * w[bj][n];
                    if (!is_ctx) {
                        const int t = row & (SEQ - 1), pos = (fq >> 1) ? (t & 63) : (t >> 6);
                        const f32x4* tp = (const f32x4*)(rope + (size_t)(pos * 16 + 8 * (fq & 1)) * 2);
#pragma unroll
                        for (int n = 0; n < 2; ++n) {
                            const f32x4 cs0 = tp[2 * n], cs1 = tp[2 * n + 1];
                            const f32x4 cv = {cs0[0], cs0[2], cs1[0], cs1[2]}, sv = {cs0[1], cs0[3], cs1[1], cs1[3]};
                            const f32x4 x1 = v[0][n], x2 = v[1][n];
                            v[0][n] = x1 * cv - x2 * sv; v[1][n] = x2 * cv + x1 * sv;
                        }
                    }
                    bf16_t* rp = P + (size_t)row * DIN + colw;
#pragma unroll
                    for (int bj = 0; bj < 2; ++bj) { u32x4 o; o.x = cvtpk(v[bj][0][0], v[bj][0][1]); o.y = cvtpk(v[bj][0][2], v[bj][0][3]); o.z = cvtpk(v[bj][1][0], v[bj][1][1]); o.w = cvtpk(v[bj][1][2], v[bj][1][3]);
                        *(u32x4*)(rp + 16 * bj) = o; }
                }
        } else {
            const bool act = (type == 1 || type == 5);
#pragma unroll
            for (int ai = 0; ai < 2; ++ai)
#pragma unroll
                for (int m = 0; m < 4; ++m) {
                    const int row = u.pm * 256 + ai * 128 + wr * 64 + m * 16 + fr;
                    bf16_t* rp = P + (size_t)row * DIN + colw;
#pragma unroll
                    for (int bj = 0; bj < 2; ++bj) { f32x4 x0 = acc[ai][bj][m][0], x1 = acc[ai][bj][m][1];
                        if (act) { x0[0] = silu_f(x0[0]); x0[1] = silu_f(x0[1]); x0[2] = silu_f(x0[2]); x0[3] = silu_f(x0[3]); x1[0] = silu_f(x1[0]); x1[1] = silu_f(x1[1]); x1[2] = silu_f(x1[2]); x1[3] = silu_f(x1[3]); }
                        u32x4 o; o.x = cvtpk(x0[0], x0[1]); o.y = cvtpk(x0[2], x0[3]); o.z = cvtpk(x1[0], x1[1]); o.w = cvtpk(x1[2], x1[3]); *(u32x4*)(rp + 16 * bj) = o; }
                }
        }
    }
};
struct EpiFold {
    bf16_t* WT;
    DI void operator()(const f32x4 (&acc)[2][2][4][2], const pg8::Unit& u, int wr, int wc, int fr, int fq) const {
        const int rbase = (u.pm >> 2) * DIN + (u.pm & 3) * 256 + wr * 64 + fr; const int col0 = u.pn * 256 + wc * 32 + 4 * fq;
#pragma unroll
        for (int ai = 0; ai < 2; ++ai)
#pragma unroll
            for (int m = 0; m < 4; ++m) { bf16_t* rp = WT + (size_t)(rbase + ai * 128 + m * 16) * DM + col0;
#pragma unroll
                for (int bj = 0; bj < 2; ++bj)
#pragma unroll
                    for (int n = 0; n < 2; ++n) { const f32x4 x = acc[ai][bj][m][n]; u32x2 o; o.x = cvtpk(x[0], x[1]); o.y = cvtpk(x[2], x[3]); *(u32x2*)(rp + bj * 128 + n * 16) = o; } }
    }
};
struct EpiOut {
    const float* xin; const bf16_t* xin_b; const float* cin; float* xout; bf16_t* xout_b; float* cout; const float* modl; int layer;
    DI void operator()(const f32x4 (&acc)[2][2][4][2], const pg8::Unit& u, int wr, int wc, int fr, int fq) const {
        const bool is_ctx = u.pm >= 128; const int b = is_ctx ? 8 : (u.pm >> 4);
        const int mode = is_ctx ? 0 : (layer == 0 ? 1 : 2);
        const float* gate = modl + b * DIN + 2 * DM;
        const int row0 = (is_ctx ? (u.pm - 128) : u.pm) * 256 + wr * 64 + fr; const int col0 = u.pn * 256 + wc * 32 + 8 * fq;
        f32x4 gv[2][2];
#pragma unroll
        for (int bj = 0; bj < 2; ++bj)
#pragma unroll
            for (int n = 0; n < 2; ++n) gv[bj][n] = *(const f32x4*)(gate + col0 + bj * 128 + 4 * n);
#pragma unroll
        for (int ai = 0; ai < 2; ++ai)
#pragma unroll
            for (int m = 0; m < 4; ++m) { const size_t off = (size_t)(row0 + ai * 128 + m * 16) * DM + col0;
#pragma unroll
                for (int bj = 0; bj < 2; ++bj) {
                    f32x4 x0, x1;
                    if (mode == 2) { const u32x4 w = *(const u32x4*)(xin_b + off + bj * 128);
                        x0 = (f32x4){bf_lo(w.x), bf_hi(w.x), bf_lo(w.y), bf_hi(w.y)}; x1 = (f32x4){bf_lo(w.z), bf_hi(w.z), bf_lo(w.w), bf_hi(w.w)}; }
                    else { const float* src = is_ctx ? cin : xin; x0 = *(const f32x4*)(src + off + bj * 128); x1 = *(const f32x4*)(src + off + bj * 128 + 4); }
                    const f32x4 y0 = x0 + gv[bj][0] * acc[ai][bj][m][0], y1 = x1 + gv[bj][1] * acc[ai][bj][m][1];
                    if (mode == 1) { u32x4 o; o.x = cvtpk(y0[0], y0[1]); o.y = cvtpk(y0[2], y0[3]); o.z = cvtpk(y1[0], y1[1]); o.w = cvtpk(y1[2], y1[3]); *(u32x4*)(xout_b + off + bj * 128) = o; }
                    else { float* dst = is_ctx ? cout : xout; *(f32x4*)(dst + off + bj * 128) = y0; *(f32x4*)(dst + off + bj * 128 + 4) = y1; }
                }
            }
    }
};
struct FoldOrder {
    const char* pwt; const char* wv; int c;
    DI bool next(int i, pg8::Unit& u) const { if (i != 0 || c >= 64) return false; u.pm = c >> 3; u.pn = c & 7; return true; }
    DI const char* aptr(const pg8::Unit& u) const { return pwt + (size_t)u.pm * 256 * 256 * 2; }
    DI const char* bptr(const pg8::Unit& u) const { return wv + (size_t)(u.pm >> 2) * DM * 1024 * 2 + ((size_t)u.pn * 256 * 1024 + (size_t)(u.pm & 3) * 256) * 2; }
};

DI int perm_row(int N) { return (N & ~255) + 128 * ((N >> 4) & 1) + 32 * ((N >> 6) & 3) + 16 * ((N >> 2) & 1) + 8 * ((N >> 5) & 1) + 4 * ((N >> 3) & 1) + (N & 3); }
DI int perm_row_out(int N) { return (N & ~31) + 16 * ((N >> 2) & 1) + 4 * ((N >> 3) & 3) + (N & 3); }
DI void transpose_tile(const float* src, int ld_src, int k0, int n0, bf16_t* dst, int ld_dst, int perm, LAS float* tile) {
    const int t = threadIdx.x;
    f32x4 v[4][2];
#pragma unroll
    for (int q = 0; q < 4; ++q)
#pragma unroll
        for (int i = 0; i < 2; ++i) { const int r = (t >> 4) + 32 * i, c4 = (t & 15) * 4; v[q][i] = *(const f32x4*)(src + (size_t)(k0 + r) * ld_src + n0 + 64 * q + c4); }
#pragma unroll
    for (int q = 0; q < 4; ++q)
#pragma unroll
        for (int i = 0; i < 2; ++i) { const int r = (t >> 4) + 32 * i, c4 = (t & 15) * 4; LAS float* tp = tile + q * (64 * 65) + r * 65 + c4;
            tp[0] = v[q][i][0]; tp[1] = v[q][i][1]; tp[2] = v[q][i][2]; tp[3] = v[q][i][3]; }
    __syncthreads();
    const int n = t >> 3, k8 = (t & 7) * 8;
#pragma unroll
    for (int q = 0; q < 4; ++q) { const LAS float* s = tile + q * (64 * 65) + k8 * 65 + n;
        u32x4 o; o.x = cvtpk(s[0 * 65], s[1 * 65]); o.y = cvtpk(s[2 * 65], s[3 * 65]); o.z = cvtpk(s[4 * 65], s[5 * 65]); o.w = cvtpk(s[6 * 65], s[7 * 65]);
        const int N = n0 + 64 * q + n, drow = (perm == 1) ? perm_row(N) : ((perm == 2) ? perm_row_out(N) : N);
        *(u32x4*)(dst + (size_t)drow * ld_dst + k0 + k8) = o; }
    __syncthreads();
}
DI void mod_job(const Args& a, int l, int j, LAS float* sc, float* mod) {
    const int t = threadIdx.x, lane = t & 63, wid = t >> 6;
    const float* cc = a.in[1]; const float* cctx = a.in[3];
    for (int idx = t; idx < 9 * DM; idx += NTHREADS) { const int b = idx >> 11, k = idx & (DM - 1); const float v = (b < 8) ? cc[b * DM + k] : cctx[k]; sc[idx] = silu_f(v); }
    __syncthreads();
    const int n0 = 128 * j;
    const float* W = a.in[5] + (size_t)l * DM * DIN + n0 + 2 * lane;
    f32x2 acc[9];
#pragma unroll
    for (int b = 0; b < 9; ++b) acc[b] = (f32x2){0.f, 0.f};
    const int kb = wid * 256;
    for (int k = kb; k < kb + 256; k += 4) {
        f32x2 wv[4];
#pragma unroll
        for (int q = 0; q < 4; ++q) wv[q] = *(const f32x2*)(W + (size_t)(k + q) * DIN);
#pragma unroll
        for (int b = 0; b < 9; ++b) { const f32x4 s = *(const LAS f32x4*)(sc + b * DM + k);
            acc[b] += wv[0] * s[0]; acc[b] += wv[1] * s[1]; acc[b] += wv[2] * s[2]; acc[b] += wv[3] * s[3]; }
    }
    __syncthreads();
#pragma unroll
    for (int b = 0; b < 9; ++b) { sc[(wid * 9 + b) * 128 + 2 * lane] = acc[b][0]; sc[(wid * 9 + b) * 128 + 2 * lane + 1] = acc[b][1]; }
    __syncthreads();
    for (int o = t; o < 9 * 128; o += NTHREADS) { const int b = o >> 7, n = o & 127; float s = 0.f;
#pragma unroll
        for (int w = 0; w < 8; ++w) s += sc[(w * 9 + b) * 128 + n];
        mod[((size_t)l * 9 + b) * DIN + n0 + n] = s + a.in[6][(size_t)l * DIN + n0 + n]; }
    __syncthreads();
}
constexpr int P0_PER_L = 640 + 256 + 16 + 256, P0_NO = 1 + 2 * P0_PER_L;
DI void p0_other(const Args& a, LAS float* lf, int r) {
    const int t = threadIdx.x;
    unsigned char* ws = a.ws;
    bf16_t* WTIN = (bf16_t*)(ws + WS_WTIN); bf16_t* WTOUT = (bf16_t*)(ws + WS_WTOUT); bf16_t* WV = (bf16_t*)(ws + WS_WV); bf16_t* PWT = (bf16_t*)(ws + WS_PWT);
    float* rope = (float*)(ws + WS_ROPE);
    if (r < 1) { for (int e = t; e < 1024; e += NTHREADS) { const int pos = e >> 4, i = e & 15; const float inv = powf(10000.0f, -(float)i / 16.0f); const float ang = (float)pos * inv;
                    rope[2 * e] = cosf(ang); rope[2 * e + 1] = sinf(ang); } return; } r -= 1;
    const int l = r / P0_PER_L; r %= P0_PER_L;
    if (r < 640) { const int kt = r / 20, nt = r % 20; transpose_tile(a.in[7] + (size_t)l * DM * DIN, DIN, kt * 64, 1024 + nt * 256, WTIN + (size_t)l * DIN * DM, DM, 1, lf); return; } r -= 640;
    if (r < 256) { const int kt = r / 8, nt = r % 8; transpose_tile(a.in[17] + (size_t)l * DM * DM, DM, kt * 64, nt * 256, WTOUT + (size_t)l * DM * DM, DM, 2, lf); return; } r -= 256;
    if (r < 16) { const int g = r / 4, kt = r % 4; transpose_tile(a.in[8] + (size_t)(l * 4 + g) * 65536, 256, kt * 64, 0, PWT + (size_t)(l * 4 + g) * 65536, 256, 1, lf); return; } r -= 16;
    {
        const float* src = a.in[7] + (size_t)l * DM * DIN; bf16_t* dst = WV + (size_t)l * DM * 1024;
#pragma unroll
        for (int i = 0; i < 4; ++i) { const int e = (t + NTHREADS * i) * 4, row = 8 * r + (e >> 10), col = e & 1023; const f32x4 v = *(const f32x4*)(src + (size_t)row * DIN + col);
            u32x2 o; o.x = cvtpk(v[0], v[1]); o.y = cvtpk(v[2], v[3]); *(u32x2*)(dst + (size_t)row * 1024 + col) = o; }
    }
}
DI void p0_phase(const Args& a, LAS unsigned char* lds) {
    float* mod = (float*)(a.ws + WS_MOD);
    LAS float* lf = (LAS float*)lds;
    const int G = gridDim.x, b = blockIdx.x;
    constexpr int HI = 3, NH = 96 * HI;
    if (G > 192) {
        if (b < 96) { mod_job(a, b / 48, b % 48, lf, mod); for (int i = 0; i < HI; ++i) p0_other(a, lf, P0_NO - 1 - (b + 96 * i)); }
        else for (int j = b - 96; j < P0_NO - NH; j += G - 96) p0_other(a, lf, j);
    } else {
        for (int job = b; job < 96 + P0_NO; job += G) { if (job < 96) mod_job(a, job / 48, job % 48, lf, mod); else p0_other(a, lf, job - 96); }
    }
}

DI void p1_row(f32x4 (&v)[4][2], const f32x4 (&g)[4][2], const f32x4 (&sh)[4][2], bf16_t* hrow, int lane) {
    float ss = 0.f;
#pragma unroll
    for (int j = 0; j < 4; ++j)
#pragma unroll
        for (int q = 0; q < 2; ++q) { const f32x4 s = v[j][q] * v[j][q]; ss += (s[0] + s[1]) + (s[2] + s[3]); }
    const float rinv = rsqrtf(wave_sum(ss) * (1.0f / DM) + EPS);
#pragma unroll
    for (int j = 0; j < 4; ++j) { const int k = (j * 64 + lane) * 8;
        const f32x4 o0 = v[j][0] * rinv * g[j][0] + sh[j][0], o1 = v[j][1] * rinv * g[j][1] + sh[j][1];
        u32x4 p; p.x = cvtpk(o0[0], o0[1]); p.y = cvtpk(o0[2], o0[3]); p.z = cvtpk(o1[0], o1[1]); p.w = cvtpk(o1[2], o1[3]);
        *(u32x4*)(hrow + k) = p; }
}
DI void p1_mod(f32x4 (&g)[4][2], f32x4 (&sh)[4][2], const float* nw, const float* modl, int b, int lane) {
    const float* shift = modl + b * DIN; const float* scale = shift + DM;
#pragma unroll
    for (int j = 0; j < 4; ++j)
#pragma unroll
        for (int q = 0; q < 2; ++q) { const int k = (j * 64 + lane) * 8 + 4 * q; g[j][q] = *(const f32x4*)(nw + k) * (1.0f + *(const f32x4*)(scale + k)); sh[j][q] = *(const f32x4*)(shift + k); }
}
DI void p1_prep(const float* xin, const bf16_t* xin_b, const float* cin, const float* nw, const float* modl, bf16_t* H) {
    int t = threadIdx.x; asm volatile("" : "+v"(t));
    const int lane = t & 63, wid = t >> 6;
    const int gw = blockIdx.x * 8 + wid, NGW = gridDim.x * 8;
    f32x4 g[4][2], sh[4][2], v[4][2];
    for (int b = 0; b < NB; ++b) {
        if ((gw % NB) != b) continue;
        p1_mod(g, sh, nw, modl, b, lane);
        const int per = NGW / NB;
        for (int r = gw / NB; r < SEQ; r += per) { const int row = b * SEQ + r;
            if (xin_b != nullptr) {
#pragma unroll
                for (int j = 0; j < 4; ++j) { const u32x4 w = *(const u32x4*)(xin_b + (size_t)row * DM + (j * 64 + lane) * 8);
                    v[j][0] = (f32x4){bf_lo(w.x), bf_hi(w.x), bf_lo(w.y), bf_hi(w.y)}; v[j][1] = (f32x4){bf_lo(w.z), bf_hi(w.z), bf_lo(w.w), bf_hi(w.w)}; }
            } else {
#pragma unroll
                for (int j = 0; j < 4; ++j)
#pragma unroll
                    for (int q = 0; q < 2; ++q) v[j][q] = *(const f32x4*)(xin + (size_t)row * DM + (j * 64 + lane) * 8 + 4 * q);
            }
            p1_row(v, g, sh, H + (size_t)row * DM, lane);
        }
    }
    p1_mod(g, sh, nw, modl, 8, lane);
    for (int r = gw; r < MC; r += NGW) {
#pragma unroll
        for (int j = 0; j < 4; ++j)
#pragma unroll
            for (int q = 0; q < 2; ++q) v[j][q] = *(const f32x4*)(cin + (size_t)r * DM + (j * 64 + lane) * 8 + 4 * q);
        p1_row(v, g, sh, H + (size_t)(ML + r) * DM, lane);
    }
}

DI void glds16(const void* gbase, unsigned voff, unsigned lds_dst) {
    unsigned keep;
    asm volatile("s_mov_b32 %0, m0\n\ts_mov_b32 m0, %3\n\ts_nop 0\n\tglobal_load_lds_dwordx4 %1, %2\n\ts_mov_b32 m0, %0" : "=&s"(keep) : "v"(voff), "s"(gbase), "s"(lds_dst) : "memory");
}
DI float fadd_s(float a, float b) { float r; asm("v_add_f32_e32 %0, %1, %2" : "=v"(r) : "v"(a), "v"(b)); return r; }
#define ATT_WAIT_BAR() asm volatile("s_waitcnt vmcnt(0) lgkmcnt(0)\n\ts_barrier" ::: "memory")
DI void attn_unit(LAS unsigned char* lds, const bf16_t* P, bf16_t* Am, int qrow0, int h, int ntiles, int krow_ctx, int krow_lat,
                  float lam, const float* subw, float outscale) {
    int tid = threadIdx.x; asm volatile("" : "+v"(tid));
    const int lane = tid & 63, r32 = lane & 31, hi = lane >> 5;
    const int wid = __builtin_amdgcn_readfirstlane(tid >> 6), g = wid & 3, n = wid >> 2;
    const unsigned lds0 = (unsigned)(uintptr_t)lds;
    const int kkey = 8 * wid + (lane >> 3);
    const unsigned koff = (unsigned)(kkey * DIN + O_K + h * 128 + (((lane & 7) ^ ((kkey >> 1) & 7)) * 8)) * 2u;
    const unsigned voff = (unsigned)(kkey * DIN + O_V + h * 128 + (((lane & 7) ^ (4 * ((lane >> 4) & 1))) * 8)) * 2u;
    const unsigned kdst = lds0 + wid * 1024, vdst = lds0 + 49152 + wid * 1024;
#define ATT_TROW(t) (((t) < 4) ? krow_ctx + 64 * (t) : krow_lat + 64 * ((t) - 4))
#define ATT_DMA_KV(t, buf) do { const bf16_t* base_ = P + (size_t)ATT_TROW(t) * DIN; const unsigned bo_ = (unsigned)(buf) * 16384u; \
        glds16(base_, koff, (unsigned)__builtin_amdgcn_readfirstlane(kdst + bo_)); glds16(base_ + 64, koff, (unsigned)__builtin_amdgcn_readfirstlane(kdst + bo_ + 8192u)); \
        glds16(base_, voff, (unsigned)__builtin_amdgcn_readfirstlane(vdst + bo_)); glds16(base_ + 64, voff, (unsigned)__builtin_amdgcn_readfirstlane(vdst + bo_ + 8192u)); } while (0)
    ATT_DMA_KV(0, 0); ATT_DMA_KV(1, 1);
    bf16x8 qa[4];
    LAS bf16x8* qbl = (LAS bf16x8*)(lds + 98304 + wid * 4096) + lane;
    { const bf16_t* qp = P + (size_t)(qrow0 + 64 * g + r32) * DIN + O_Q + h * 128 + n * 64 + hi * 8;
#pragma unroll
      for (int s = 0; s < 4; ++s) { qa[s] = *(const bf16x8*)(qp + 16 * s); qbl[64 * s] = *(const bf16x8*)(qp + (size_t)32 * DIN + 16 * s); } }
    const unsigned kb_off = n * 8192 + r32 * 128;
    unsigned ksl[4];
#pragma unroll
    for (int s = 0; s < 4; ++s) ksl[s] = (unsigned)(((2 * s + hi) ^ ((r32 >> 1) & 7)) * 16);
    unsigned vb_par[2];
#pragma unroll
    for (int par = 0; par < 2; ++par) { const int q4 = (lane & 15) >> 2, p4 = lane & 3;
        vb_par[par] = 49152 + (4 * hi + q4) * 128 + (4 * (par ^ ((q4 >> 1) & 1)) + 2 * ((lane >> 4) & 1) + (p4 >> 1)) * 16 + (p4 & 1) * 8; }
    f32x16 oa[4], ob[4];
#pragma unroll
    for (int r = 0; r < 16; ++r) { oa[0][r] = 0.f; oa[1][r] = 0.f; oa[2][r] = 0.f; oa[3][r] = 0.f; ob[0][r] = 0.f; ob[1][r] = 0.f; ob[2][r] = 0.f; ob[3][r] = 0.f; }
    float lsa = 0.f, lsb = 0.f;
    ATT_WAIT_BAR();
#define ATT_VTR(p) __builtin_bit_cast(s16x4, __builtin_amdgcn_ds_read_tr16_b64_v4i16((LAS s16x4*)(p)))
#define ATT_QKP(QF, LS, PW) do { \
        _Pragma("unroll") for (int kb = 0; kb < 2; ++kb) {       \
            f32x16 x0; \
            _Pragma("unroll") for (int r = 0; r < 16; ++r) x0[r] = 0.f; \
            _Pragma("unroll") for (int s = 0; s < 4; ++s) x0 = __builtin_amdgcn_mfma_f32_32x32x16_bf16(*(const LAS bf16x8*)(kp + ksl[s] + kb * 4096), QF(s), x0, 0, 0, 0); \
            float ac0 = 0.f, ac1 = 0.f; \
            _Pragma("unroll") for (int r = 0; r < 16; r += 2) { \
                x0[r] = __builtin_amdgcn_exp2f(x0[r]); x0[r + 1] = __builtin_amdgcn_exp2f(x0[r + 1]); \
                ac0 = fadd_s(ac0, x0[r]); ac1 = fadd_s(ac1, x0[r + 1]); } \
            LS += ac0 + ac1; \
            _Pragma("unroll") for (int q = 0; q < 4; ++q) { PW[2 * kb][q] = cvtpk(x0[2 * q], x0[2 * q + 1]); PW[2 * kb + 1][q] = cvtpk(x0[8 + 2 * q], x0[8 + 2 * q + 1]); } \
        } \
    } while (0)
    int s0 = 0, s1 = 1, s2 = 2;
    for (int t = 0; t < ntiles; ++t) {
        const bool more = (t + 2 < ntiles);
        if (more) ATT_DMA_KV(t + 2, s2);
        LAS unsigned char* kp = lds + s0 * 16384 + kb_off;
        LAS unsigned char* vp0 = lds + s0 * 16384 + vb_par[0];
        LAS unsigned char* vp1 = lds + s0 * 16384 + vb_par[1];
        u32x4 pwa[4], pwb[4];
#define ATT_QA(s) qa[s]
#define ATT_QB(s) qbl[64 * (s)]
        ATT_QKP(ATT_QA, lsa, pwa);
        ATT_QKP(ATT_QB, lsb, pwb);
#undef ATT_QA
#undef ATT_QB
        {
            s16x4 vl[2][2], vh[2][2];
#pragma unroll
            for (int i = 0; i < 2; ++i) { LAS unsigned char* vq = (i ? vp1 : vp0); vl[0][i] = ATT_VTR(vq); vh[0][i] = ATT_VTR(vq + 1024); }
#pragma unroll
            for (int gi = 0; gi < 8; ++gi) { const int ks = gi >> 1, dp = gi & 1;
                if (gi < 7) { const int ks2 = (gi + 1) >> 1, dp2 = (gi + 1) & 1;
#pragma unroll
                    for (int i = 0; i < 2; ++i) { LAS unsigned char* vq = (i ? vp1 : vp0) + dp2 * 8192 + ks2 * 2048; vl[(gi + 1) & 1][i] = ATT_VTR(vq); vh[(gi + 1) & 1][i] = ATT_VTR(vq + 1024); } }
                __builtin_amdgcn_sched_barrier(0x406);
#pragma unroll
                for (int i = 0; i < 2; ++i) { const int d0 = 2 * dp + i; const s16x4 lo = vl[gi & 1][i], hh = vh[gi & 1][i];
                    const bf16x8 vf = {lo[0], lo[1], lo[2], lo[3], hh[0], hh[1], hh[2], hh[3]};
                    oa[d0] = __builtin_amdgcn_mfma_f32_32x32x16_bf16(vf, __builtin_bit_cast(bf16x8, pwa[ks]), oa[d0], 0, 0, 0);
                    ob[d0] = __builtin_amdgcn_mfma_f32_32x32x16_bf16(vf, __builtin_bit_cast(bf16x8, pwb[ks]), ob[d0], 0, 0, 0); }
                __builtin_amdgcn_sched_barrier(0x406);
            }
        }
        ATT_WAIT_BAR();
        { const int tmp = s0; s0 = s1; s1 = s2; s2 = tmp; }
    }
#undef ATT_QKP
#undef ATT_DMA_KV
#undef ATT_TROW
#undef ATT_VTR
    lsa = sum_x32(lsa); lsb = sum_x32(lsb);
    const float inva = 1.0f / lsa, invb = 1.0f / lsb;
    int tid2 = threadIdx.x; asm volatile("" : "+v"(tid2));
    const int lane2 = tid2 & 63, r32e = lane2 & 31, hie = lane2 >> 5;
    LAS float* xch = (LAS float*)lds + g * 8192;
    if (n == 1) { const float sa = inva * lam, sb = invb * lam;
#pragma unroll
        for (int d0 = 0; d0 < 4; ++d0)
#pragma unroll
            for (int r = 0; r < 16; ++r) { xch[(d0 * 16 + r) * 64 + lane2] = oa[d0][r] * sa; xch[4096 + (d0 * 16 + r) * 64 + lane2] = ob[d0][r] * sb; } }
    __syncthreads();
    if (n == 0) {
#pragma unroll
        for (int half = 0; half < 2; ++half) {
            float ss = 0.f; const float inv = half ? invb : inva;
#pragma unroll
            for (int d0 = 0; d0 < 4; ++d0)
#pragma unroll
                for (int r = 0; r < 16; ++r) { const float v = (half ? ob[d0][r] : oa[d0][r]) * inv - xch[half * 4096 + (d0 * 16 + r) * 64 + lane2]; if (half) ob[d0][r] = v; else oa[d0][r] = v; ss += v * v; }
            ss = sum_x32(ss);
            const float rr = rsqrtf(ss * (1.0f / 128.0f) + EPS) * outscale;
            LAS float* stg = xch + half * 4096;
#pragma unroll
            for (int d0 = 0; d0 < 4; ++d0)
#pragma unroll
                for (int rg = 0; rg < 4; ++rg) { const int e0 = 32 * d0 + 8 * rg, cc = 8 * d0 + 2 * rg + hie;
                    const f32x4 w4 = *(const f32x4*)(subw + e0 + 4 * hie);
                    const float v0 = half ? ob[d0][4 * rg + 0] : oa[d0][4 * rg + 0], v1 = half ? ob[d0][4 * rg + 1] : oa[d0][4 * rg + 1];
                    const float v2 = half ? ob[d0][4 * rg + 2] : oa[d0][4 * rg + 2], v3 = half ? ob[d0][4 * rg + 3] : oa[d0][4 * rg + 3];
                    const f32x4 tv = {v0 * rr * w4[0], v1 * rr * w4[1], v2 * rr * w4[2], v3 * rr * w4[3]};
                    *(LAS f32x4*)(stg + r32e * 128 + ((cc ^ r32e) & 31) * 4) = tv; }
            const int k16 = lane2 & 15;
#pragma unroll
            for (int i = 0; i < 8; ++i) { const int R = 4 * i + (lane2 >> 4);
                const f32x4 ta = *(const LAS f32x4*)(stg + R * 128 + (((2 * k16) ^ R) & 31) * 4), tb = *(const LAS f32x4*)(stg + R * 128 + (((2 * k16 + 1) ^ R) & 31) * 4);
                const size_t row = (size_t)(qrow0 + 64 * g + 32 * half + R);
                const u32x4 sg = *(const u32x4*)(P + row * DIN + O_AG + h * 128 + 8 * k16);
                u32x4 ov; ov.x = cvtpk(ta[0] * bf_lo(sg.x), ta[1] * bf_hi(sg.x)); ov.y = cvtpk(ta[2] * bf_lo(sg.y), ta[3] * bf_hi(sg.y));
                ov.z = cvtpk(tb[0] * bf_lo(sg.z), tb[1] * bf_hi(sg.z)); ov.w = cvtpk(tb[2] * bf_lo(sg.w), tb[3] * bf_hi(sg.w));
                *(u32x4*)(Am + row * DM + 1024 + h * 128 + 8 * k16) = ov; }
        }
    }
    __syncthreads();
}

template <int GI>
DI void pool_group(const bf16_t* P, bf16_t* Am, const float* pscale, int nrows, int tid) {
    constexpr int HALFW = 1 << GI, W = 2 * HALFW, R = 4, NV = R + W - 1;
    const long total = (long)(nrows / R) * 32;
    for (long idx = (long)blockIdx.x * NTHREADS + tid; idx < total; idx += (long)gridDim.x * NTHREADS) {
        const int row0 = (int)(idx >> 5) * R, c0 = GI * 256 + (int)(idx & 31) * 8;
        int base, tt0, Ls;
        if (row0 < ML) { base = row0 & ~(SEQ - 1); tt0 = row0 & (SEQ - 1); Ls = SEQ; } else { const int r2 = row0 - ML; base = ML + (r2 & ~(CTX - 1)); tt0 = r2 & (CTX - 1); Ls = CTX; }
        u32x4 v[NV];
#pragma unroll
        for (int j = 0; j < NV; ++j) { const int q = min(max(tt0 - HALFW + j, 0), Ls - 1); v[j] = *(const u32x4*)(P + (size_t)(base + q) * DIN + O_PV + c0); }
        u32x4 gv[R];
#pragma unroll
        for (int i = 0; i < R; ++i) gv[i] = *(const u32x4*)(P + (size_t)(row0 + i) * DIN + O_PG + c0);
        const f32x4 p0 = *(const f32x4*)(pscale + c0), p1 = *(const f32x4*)(pscale + c0 + 4);
#pragma unroll
        for (int i = 0; i < R; ++i) {
            float s[8];
#pragma unroll
            for (int e = 0; e < 8; ++e) s[e] = 0.f;
            const int tt = tt0 + i;
#pragma unroll
            for (int j = i; j < i + W; ++j) { const int q = tt0 - HALFW + j; const float m = (q >= 0 && q < Ls) ? 1.0f : 0.0f;
                s[0] += m * bf_lo(v[j].x); s[1] += m * bf_hi(v[j].x); s[2] += m * bf_lo(v[j].y); s[3] += m * bf_hi(v[j].y);
                s[4] += m * bf_lo(v[j].z); s[5] += m * bf_hi(v[j].z); s[6] += m * bf_lo(v[j].w); s[7] += m * bf_hi(v[j].w); }
            const int lo = max(tt - HALFW, 0), hi2 = min(tt + HALFW, Ls);
            const float rc = 1.0f / (float)(hi2 - lo);
            const u32x4 tv = v[i + HALFW], g4 = gv[i];
            float y[8];
            y[0] = (s[0] * rc - bf_lo(tv.x)) * p0[0] * bf_lo(g4.x); y[1] = (s[1] * rc - bf_hi(tv.x)) * p0[1] * bf_hi(g4.x);
            y[2] = (s[2] * rc - bf_lo(tv.y)) * p0[2] * bf_lo(g4.y); y[3] = (s[3] * rc - bf_hi(tv.y)) * p0[3] * bf_hi(g4.y);
            y[4] = (s[4] * rc - bf_lo(tv.z)) * p1[0] * bf_lo(g4.z); y[5] = (s[5] * rc - bf_hi(tv.z)) * p1[1] * bf_hi(g4.z);
            y[6] = (s[6] * rc - bf_lo(tv.w)) * p1[2] * bf_lo(g4.w); y[7] = (s[7] * rc - bf_hi(tv.w)) * p1[3] * bf_hi(g4.w);
            u32x4 ov; ov.x = cvtpk(y[0], y[1]); ov.y = cvtpk(y[2], y[3]); ov.z = cvtpk(y[4], y[5]); ov.w = cvtpk(y[6], y[7]);
            *(u32x4*)(Am + (size_t)(row0 + i) * DM + c0) = ov;
        }
    }
}
DI void p3_phase(const Args& a, LAS unsigned char* lds, int l) {
    int tid = threadIdx.x; asm volatile("" : "+v"(tid));
    const int lane = tid & 63;
    unsigned char* ws = a.ws;
    const bf16_t* P = (const bf16_t*)(ws + WS_P); bf16_t* Am = (bf16_t*)(ws + WS_H);
    const float lam_init = (l == 0) ? 0.2f : (0.8f - 0.6f * 0.7408182206817179f);
    const float d1 = wave_sum(a.in[12][l * 64 + lane] * a.in[13][l * 64 + lane]);
    const float d2 = wave_sum(a.in[14][l * 64 + lane] * a.in[15][l * 64 + lane]);
    const float lam = __builtin_bit_cast(float, __builtin_amdgcn_readfirstlane(__builtin_bit_cast(int, expf(d1) - expf(d2) + lam_init)));
    const float outscale = __builtin_bit_cast(float, __builtin_amdgcn_readfirstlane(__builtin_bit_cast(int, 1.0f - lam_init)));
    const float* subw = a.in[16] + l * 128;
    const int G = gridDim.x, c = blockIdx.x;
    const int NU = 1024 + ((l == 0) ? 64 : 0);
    for (int rep_ = 0; rep_ < REP_P3A; ++rep_)
    for (int L = c; L < NU; L += G) {
        int b, h, qrow0, ntl;
        if (L < 1024) { const int j = L >> 3, bh = (L & 7) + 8 * (j >> 4), qb = j & 15; b = bh >> 3; h = bh & 7; qrow0 = b * SEQ + qb * 256; ntl = 68; }
        else { const int e = L - 1024; b = e >> 3; h = e & 7; qrow0 = ML + b * CTX; ntl = 4; }
        attn_unit(lds, P, Am, qrow0, h, ntl, ML + b * CTX, b * SEQ, lam, subw, outscale);
    }
    const float* pscale = a.in[9] + l * 1024;
    const int nrows = (l == 0) ? MT : ML;
    int tid3 = threadIdx.x; asm volatile("" : "+v"(tid3));
    for (int rep_ = 0; rep_ < REP_P3B; ++rep_) {
        pool_group<0>(P, Am, pscale, nrows, tid3); pool_group<1>(P, Am, pscale, nrows, tid3);
        pool_group<2>(P, Am, pscale, nrows, tid3); pool_group<3>(P, Am, pscale, nrows, tid3);
    }
}

#define XB_TMO      128
#define XB_XCNT(j)  (256  + 64 * (j))
#define XB_XSUB(j)  (1280 + 64 * (j))
#define XB_XGEN(j)  (2304 + 64 * (j))
#define XB_TOP      3328
#define XB_TOPGEN   3392
#define XCD_BAR_WORDS 3456
#define XB_SPIN_CAP (1u << 18)

__device__ __forceinline__ unsigned xb_ld(unsigned* p)              { return __hip_atomic_load(p, __ATOMIC_RELAXED, __HIP_MEMORY_SCOPE_AGENT); }
__device__ __forceinline__ unsigned xb_add(unsigned* p, unsigned v) { return __hip_atomic_fetch_add(p, v, __ATOMIC_RELAXED, __HIP_MEMORY_SCOPE_AGENT); }
__device__ __forceinline__ unsigned xb_xcc_id() { return (unsigned)__builtin_amdgcn_s_getreg((3 << 11) | 20) & 0xFu; }
#define XB_SPIN(cond, bar) do { unsigned _sp = 0; while (cond) { __builtin_amdgcn_s_sleep(1); \
    if ((++_sp & 255u) == 0u) { if (xb_ld(&(bar)[XB_TMO])) break; if (_sp > XB_SPIN_CAP) { atomicAdd(&(bar)[XB_TMO], 1u); break; } } } } while (0)

struct XcdBarrier {
    unsigned* bar; unsigned x;
    volatile LAS unsigned* st;
};

__device__ __forceinline__ XcdBarrier xcd_barrier_post(unsigned* bar, volatile LAS unsigned* st) {
    XcdBarrier b; b.bar = bar; b.x = xb_xcc_id(); b.st = st;
    if (threadIdx.x == 0) (void)xb_add(&bar[XB_XCNT(b.x)], 1u);
    return b;
}
__device__ __forceinline__ void xcd_barrier_complete(unsigned* bar, unsigned x, unsigned& nloc, unsigned& nx) {
    const unsigned G = gridDim.x * gridDim.y * gridDim.z;
    unsigned sum, cnt, mine, sp = 0u;
    for (;;) {
        sum = 0u; cnt = 0u; mine = 0u;
#pragma unroll
        for (unsigned j = 0; j < 16; ++j) { const unsigned c = xb_ld(&bar[XB_XCNT(j)]); sum += c; cnt += (c > 0u) ? 1u : 0u; mine = (j == x) ? c : mine; }
        if (sum == G) break;
        __builtin_amdgcn_s_sleep(1);
        if ((++sp & 255u) == 0u) { if (xb_ld(&bar[XB_TMO])) break; if (sp > XB_SPIN_CAP) { atomicAdd(&bar[XB_TMO], 1u); break; } }
    }
    nloc = mine > 0u ? mine : 1u; nx = cnt > 0u ? cnt : 1u;
}

__device__ __forceinline__ void xcd_barrier(const XcdBarrier& b) {
    asm volatile("s_waitcnt vmcnt(0)" ::: "memory");
    __syncthreads();
    if (threadIdx.x == 0) {
        unsigned* bar = b.bar;
        __builtin_amdgcn_s_waitcnt(0);
        unsigned nloc = b.st[0], nx = b.st[1];
        if (nloc == 0u) { xcd_barrier_complete(bar, b.x, nloc, nx); b.st[0] = nloc; b.st[1] = nx; }
        const unsigned old = xb_add(&bar[XB_XSUB(b.x)], 1u);
        const unsigned gen = old / nloc;
        if (old + 1u == (gen + 1u) * nloc) {
            __builtin_amdgcn_fence(__ATOMIC_RELEASE, "agent");
            asm volatile("s_waitcnt vmcnt(0)" ::: "memory");
            const unsigned og = xb_add(&bar[XB_TOP], 1u);
            const unsigned tg = og / nx;
            if (og + 1u == (tg + 1u) * nx) xb_add(&bar[XB_TOPGEN], 1u);
            else XB_SPIN(xb_ld(&bar[XB_TOPGEN]) == tg, bar);
            __builtin_amdgcn_fence(__ATOMIC_ACQUIRE, "agent");
            xb_add(&bar[XB_XGEN(b.x)], 1u);
            asm volatile("s_waitcnt vmcnt(0)" ::: "memory");
        } else {
            XB_SPIN(xb_ld(&bar[XB_XGEN(b.x)]) == gen, bar);
            __builtin_amdgcn_fence(__ATOMIC_ACQUIRE, "agent");
            asm volatile("s_waitcnt vmcnt(0)" ::: "memory");
        }
    }
    __syncthreads();
}


__global__ void __launch_bounds__(NTHREADS, 2) hybrid_fwd(Args a) {
    extern __shared__ __attribute__((aligned(16))) unsigned char lds_raw[];
    LAS unsigned char* lds = (LAS unsigned char*)lds_raw;
    cg::grid_group grid = cg::this_grid();
    unsigned char* ws = a.ws;
    const int G = gridDim.x, c = blockIdx.x;
    bf16_t* WTIN = (bf16_t*)(ws + WS_WTIN); bf16_t* WTOUT = (bf16_t*)(ws + WS_WTOUT);
    bf16_t* H = (bf16_t*)(ws + WS_H); bf16_t* P = (bf16_t*)(ws + WS_P);
    bf16_t* X1b = (bf16_t*)(ws + WS_X1); float* C1 = (float*)(ws + WS_C1);
    const float* mod = (const float*)(ws + WS_MOD); const float* rope = (const float*)(ws + WS_ROPE);

    volatile LAS unsigned* bst = (volatile LAS unsigned*)(lds + 131072);
    if (threadIdx.x == 0) { bst[0] = 0u; bst[1] = 0u; }
    if (blockIdx.x == 0) for (int i = threadIdx.x; i < XCD_BAR_WORDS; i += NTHREADS) ((unsigned*)(ws + WS_CTL))[i] = 0u;
    __syncthreads();
    for (int rep_ = 0; rep_ < REP_P0; ++rep_) p0_phase(a, lds);
    grid.sync();
    const XcdBarrier xbar = xcd_barrier_post((unsigned*)(ws + WS_CTL), bst);
    {
        FoldOrder S{(const char*)(ws + WS_PWT), (const char*)(ws + WS_WV), c};
        EpiFold E{WTIN};
        pg8::gemm_phase<EpiFold, FoldOrder>(lds, pg8::Gemm{256, 1024, 256}, S, E);
    }
    for (int l = 0; l < 2; ++l) {
        const float* xin = a.in[0]; const bf16_t* xin_b = (l == 0) ? (const bf16_t*)nullptr : X1b; const float* cin = (l == 0) ? a.in[2] : C1;
        const float* modl = mod + (size_t)l * 9 * DIN;
        for (int rep_ = 0; rep_ < REP_P1; ++rep_) p1_prep(xin, xin_b, cin, a.in[4] + l * DM, modl, H);
        xcd_barrier(xbar);
        {
            pg8::GridOrder S;
            if (l == 0) S.init(H, WTIN, DM, DM, MT / 256, DIN / 256, G, c);
            else S.init(H, WTIN + (size_t)DIN * DM, DM, DM, ML / 256, DIN / 256, G, c, 64, 128, 8, 12);
            EpiIn E{P, a.in[10] + l * 64, a.in[11] + l * 64, rope};
            for (int rep_ = 0; rep_ < REP_P2; ++rep_) pg8::gemm_phase<EpiIn, pg8::GridOrder>(lds, pg8::Gemm{DM, DM, DM}, S, E);
        }
        xcd_barrier(xbar);
        p3_phase(a, lds, l);
        xcd_barrier(xbar);
        {
            pg8::GridOrder S; S.init(H, WTOUT + (size_t)l * DM * DM, DM, DM, (l == 0 ? MT : ML) / 256, DM / 256, G, c);
            EpiOut E{xin, X1b, cin, a.out, X1b, C1, modl, l};
            for (int rep_ = 0; rep_ < REP_P4; ++rep_) pg8::gemm_phase<EpiOut, pg8::GridOrder>(lds, pg8::Gemm{DM, DM, DM}, S, E);
        }
        if (l == 0) xcd_barrier(xbar);
    }
}

extern "C" void kernel_launch(void* const* d_in, const int* in_sizes, int n_in, void* d_out, int out_size, void* d_ws, size_t ws_size, hipStream_t stream) {
    static int grid = 0;
    if (grid == 0) {
        if (n_in != 18 || in_sizes[0] != ML * DM || out_size != ML * DM || ws_size < WS_END) {
            fprintf(stderr, "kernel_launch: unexpected shapes: n_in %d in0 %d out %d ws %zu (need %zu)\n", n_in, n_in > 0 ? in_sizes[0] : -1, out_size, ws_size, (size_t)WS_END); grid = -1; return; }
        int dev = 0, cus = 0, per_cu = 0;
        hipGetDevice(&dev); hipDeviceGetAttribute(&cus, hipDeviceAttributeMultiprocessorCount, dev);
        if (hipFuncSetAttribute((const void*)hybrid_fwd, hipFuncAttributeMaxDynamicSharedMemorySize, LDS_BYTES) != hipSuccess) { fprintf(stderr, "kernel_launch: hipFuncSetAttribute failed\n"); grid = -1; return; }
        if (hipOccupancyMaxActiveBlocksPerMultiprocessor(&per_cu, (const void*)hybrid_fwd, NTHREADS, LDS_BYTES) != hipSuccess || per_cu < 1) { fprintf(stderr, "kernel_launch: occupancy query gives %d\n", per_cu); per_cu = 1; }
        (void)hipGetLastError();
        grid = cus * per_cu;
    }
    if (grid < 0) return;
    Args a{};
    for (int i = 0; i < 18; ++i) a.in[i] = (const float*)d_in[i];
    a.out = (float*)d_out; a.ws = (unsigned char*)d_ws;
    void* args[] = {&a};
    hipError_t e = hipLaunchCooperativeKernel((const void*)hybrid_fwd, dim3(grid), dim3(NTHREADS), args, LDS_BYTES, stream);
    if (e != hipSuccess) fprintf(stderr, "kernel_launch: cooperative launch failed: %s (grid %d)\n", hipGetErrorString(e), grid);
}
```

```cpp
#include <hip/hip_runtime.h>
#include <hip/hip_cooperative_groups.h>
#include <cstdio>
#include <cstdint>
namespace cg = cooperative_groups;

#define LAS __attribute__((address_space(3)))
#define DI __device__ __forceinline__
typedef unsigned short bf16_t;
typedef short bf16x8 __attribute__((ext_vector_type(8)));
typedef short s16x4 __attribute__((ext_vector_type(4)));
typedef float f32x2 __attribute__((ext_vector_type(2)));
typedef float f32x4 __attribute__((ext_vector_type(4)));
typedef float f32x16 __attribute__((ext_vector_type(16)));
typedef unsigned u32x2 __attribute__((ext_vector_type(2)));
typedef unsigned u32x4 __attribute__((ext_vector_type(4)));
typedef __bf16 bf16x2_t __attribute__((ext_vector_type(2)));

constexpr int NB = 8, SEQ = 4096, DM = 2048, CTX = 256, DIN = 6144, NHEAD = 8;
constexpr int ML = NB * SEQ, MC = NB * CTX, MT = ML + MC;
constexpr int O_PV = 0, O_PG = 1024, O_Q = 2048, O_K = 3072, O_V = 4096, O_AG = 5120;
constexpr float EPS = 1e-6f;
constexpr float QSCALE = 0.125f * 1.4426950408889634f;

constexpr size_t MiB = 1u << 20;
constexpr size_t WS_WTIN = 0;
constexpr size_t WS_WTOUT = 48 * MiB;
constexpr size_t WS_WV = 64 * MiB;
constexpr size_t WS_PWT = 72 * MiB;
constexpr size_t WS_MOD = 73 * MiB;
constexpr size_t WS_ROPE = 74 * MiB;
constexpr size_t WS_CTL = 75 * MiB;
constexpr size_t WS_H = 76 * MiB;
constexpr size_t WS_P = 212 * MiB;
constexpr size_t WS_X1 = 620 * MiB;
constexpr size_t WS_C1 = 876 * MiB;
constexpr size_t WS_END = 892 * MiB;

#ifndef REP_P0
#define REP_P0 1
#endif
#ifndef REP_P1
#define REP_P1 1
#endif
#ifndef REP_P2
#define REP_P2 1
#endif
#ifndef REP_P3A
#define REP_P3A 1
#endif
#ifndef REP_P3B
#define REP_P3B 1
#endif
#ifndef REP_P4
#define REP_P4 1
#endif
constexpr int NTHREADS = 512;
constexpr int LDS_BYTES = 147456;

struct Args { const float* in[18]; float* out; unsigned char* ws; };

DI unsigned cvtpk(float lo, float hi) { f32x2 v = {lo, hi}; bf16x2_t b = __builtin_convertvector(v, bf16x2_t); return __builtin_bit_cast(unsigned, b); }
DI float bf_lo(unsigned u) { return __builtin_bit_cast(float, u << 16); }
DI float bf_hi(unsigned u) { return __builtin_bit_cast(float, u & 0xffff0000u); }
template <int K> DI float swz_xor_t(float v) { return __builtin_bit_cast(float, __builtin_amdgcn_ds_swizzle(__builtin_bit_cast(int, v), (K << 10) | 0x1f)); }
#define swz_xor(v, k) swz_xor_t<(k)>(v)
DI float sum_x32(float v) { const unsigned u = __builtin_bit_cast(unsigned, v); auto rr = __builtin_amdgcn_permlane32_swap(u, u, false, false);
    return __builtin_bit_cast(float, (unsigned)rr[0]) + __builtin_bit_cast(float, (unsigned)rr[1]); }
DI float max_x32(float v) { const unsigned u = __builtin_bit_cast(unsigned, v); auto rr = __builtin_amdgcn_permlane32_swap(u, u, false, false);
    return fmaxf(__builtin_bit_cast(float, (unsigned)rr[0]), __builtin_bit_cast(float, (unsigned)rr[1])); }
DI float wave_sum(float v) { v += swz_xor(v, 1); v += swz_xor(v, 2); v += swz_xor(v, 4); v += swz_xor(v, 8); v += swz_xor(v, 16); return sum_x32(v); }
DI float wave_max(float v) { v = fmaxf(v, swz_xor(v, 1)); v = fmaxf(v, swz_xor(v, 2)); v = fmaxf(v, swz_xor(v, 4)); v = fmaxf(v, swz_xor(v, 8)); v = fmaxf(v, swz_xor(v, 16)); return max_x32(v); }
DI float silu_f(float v) { return v * __builtin_amdgcn_rcpf(1.0f + __expf(-v)); }

namespace pg8 {
constexpr int BM = 256, BK = 64, HALF = 128, HTB = HALF * BK * 2, STAGE_BYTES = 8 * HTB, NXCD = 8, WGM = 8;
DI int lds_byte(int r, int c) { const int st = (r >> 4) * 2 + (c >> 5), rr = r & 15, cc = c & 31, ob = rr * 64 + cc * 2; return st * 1024 + (ob ^ (((ob >> 9) & 1) << 5)); }
DI void stage_rc(int b, int& R, int& C) { const int st = b / 1024, sb = b % 1024, swz = sb ^ (((sb >> 9) & 1) << 5); R = (st >> 1) * 16 + swz / 64; C = (st & 1) * 32 + (swz % 64) / 2; }

struct Unit { int pm, pn; };
struct Gemm { int lda, ldb, K; };

struct GridOrder {
    const char* A; const char* Bt; size_t tstepA, tstepB;
    int nM, nN, nwg, G, c;
    int ex_n, ex_pm0, ex_npm, ex_pn0;
    DI void init(const void* A_, const void* Bt_, int lda, int ldb, int nM_, int nN_, int G_, int c_, int ex_n_ = 0, int ex_pm0_ = 0, int ex_npm_ = 1, int ex_pn0_ = 0) {
        A = (const char*)A_; Bt = (const char*)Bt_; tstepA = (size_t)BM * lda * 2; tstepB = (size_t)BM * ldb * 2;
        nM = nM_; nN = nN_; nwg = nM * nN; G = G_; c = c_; ex_n = ex_n_; ex_pm0 = ex_pm0_; ex_npm = ex_npm_; ex_pn0 = ex_pn0_;
    }
    DI bool next(int i, Unit& u) const {
        const long L = (long)i * G + c;
        if (L >= nwg) { const int e = (int)(L - nwg); if (e >= ex_n) return false; u.pm = ex_pm0 + e % ex_npm; u.pn = ex_pn0 + e / ex_npm; return true; }
        int wgid = (int)L; { const int q = nwg / NXCD, r = nwg % NXCD, xcd = wgid % NXCD, off = wgid / NXCD; wgid = (xcd < r ? xcd * (q + 1) : r * (q + 1) + (xcd - r) * q) + off; }
        const int nig = WGM * nN, gid = wgid / nig, fm = gid * WGM, gsz = (nM - fm) < WGM ? (nM - fm) : WGM;
        u.pm = fm + ((wgid % nig) % gsz); u.pn = (wgid % nig) / gsz; return true;
    }
    DI const char* aptr(const Unit& u) const { return A + (size_t)u.pm * tstepA; }
    DI const char* bptr(const Unit& u) const { return Bt + (size_t)u.pn * tstepB; }
};

template <class Epi, class Sched>
DI void gemm_phase(LAS unsigned char* lds, const Gemm g, const Sched& S, const Epi& E) {
    int tid = threadIdx.x; asm volatile("" : "+v"(tid));
    const int wid = __builtin_amdgcn_readfirstlane(tid >> 6), lane = tid & 63, wr = wid >> 2, wc = wid & 3, fr = lane & 15, fq = lane >> 4;
    const int K = g.K, nt = K / BK;
    unsigned voffA[2], voffB[2];
#pragma unroll
    for (int i = 0; i < 2; ++i) { int R, C; stage_rc(tid * 16 + i * 8192, R, C); voffA[i] = (unsigned)(R * g.lda + C) * 2u; voffB[i] = (unsigned)(R * g.ldb + C) * 2u; }
    const size_t kstep = (size_t)(BK * 2);
    const size_t hstepA = (size_t)HALF * g.lda * 2, hstepB = (size_t)HALF * g.ldb * 2;
    const unsigned ldsw = (unsigned)wid * 1024u;
    const int aoff = lds_byte(wr * 64 + fr, fq * 8), boff = lds_byte(wc * 32 + fr, fq * 8);
#define PG8_SA(b, h) (((b) * 2 + (h)) * HTB)
#define PG8_SB(b, h) ((4 + (b) * 2 + (h)) * HTB)
#define PG8_STAGE(bufoff, gbase, voff) do { _Pragma("unroll") for (int _i = 0; _i < 2; ++_i) \
        __builtin_amdgcn_global_load_lds((const unsigned*)((const char*)(gbase) + (voff)[_i]), (LAS unsigned*)(lds + (bufoff) + ldsw + _i * 8192), 16, 0, 0); } while (0)
#define PG8_LDA(dst, b, h) do { _Pragma("unroll") for (int m = 0; m < 4; ++m) _Pragma("unroll") for (int k = 0; k < 2; ++k) dst[m][k] = *(const LAS bf16x8*)(lds + PG8_SA(b, h) + aoff + m * 2048 + k * 1024); } while (0)
#define PG8_LDB(dst, b, h) do { _Pragma("unroll") for (int n = 0; n < 2; ++n) _Pragma("unroll") for (int k = 0; k < 2; ++k) dst[n][k] = *(const LAS bf16x8*)(lds + PG8_SB(b, h) + boff + n * 2048 + k * 1024); } while (0)
#define PG8_MMA(ai, bj, At, Bt) do { __builtin_amdgcn_s_setprio(1); _Pragma("unroll") for (int m = 0; m < 4; ++m) _Pragma("unroll") for (int n = 0; n < 2; ++n) _Pragma("unroll") for (int k = 0; k < 2; ++k) \
        acc[ai][bj][m][n] = __builtin_amdgcn_mfma_f32_16x16x32_bf16(Bt[n][k], At[m][k], acc[ai][bj][m][n], 0, 0, 0); __builtin_amdgcn_s_setprio(0); } while (0)
#define PG8_WAIT_V(n) asm volatile("s_waitcnt vmcnt(" #n ")" ::: "memory")
#define PG8_WAIT_L(n) asm volatile("s_waitcnt lgkmcnt(" #n ")" ::: "memory")
#define PG8_BAR __builtin_amdgcn_s_barrier()
#define PG8_SCHED __builtin_amdgcn_sched_barrier(0)
    Unit cur, nxt; int ui = 0;
    if (!S.next(0, cur)) return;
    f32x4 acc[2][2][4][2];
#pragma unroll
    for (int a = 0; a < 2; ++a)
#pragma unroll
        for (int b = 0; b < 2; ++b)
#pragma unroll
            for (int m = 0; m < 4; ++m)
#pragma unroll
                for (int n = 0; n < 2; ++n) acc[a][b][m][n] = (f32x4){0.f, 0.f, 0.f, 0.f};
    bf16x8 At[4][2], B0[2][2], B1[2][2];
    const char* cA = S.aptr(cur); const char* cB = S.bptr(cur);
    PG8_STAGE(PG8_SB(0, 0), cB, voffB); PG8_STAGE(PG8_SB(0, 1), cB + hstepB, voffB); PG8_STAGE(PG8_SA(0, 0), cA, voffA); PG8_STAGE(PG8_SA(0, 1), cA + hstepA, voffA);
    if (wr == 1) PG8_BAR;
    PG8_WAIT_V(2); PG8_BAR;
    PG8_STAGE(PG8_SB(1, 0), cB + kstep, voffB); PG8_STAGE(PG8_SA(1, 0), cA + kstep, voffA); PG8_STAGE(PG8_SB(1, 1), cB + hstepB + kstep, voffB);
    PG8_WAIT_V(6); PG8_BAR;
    for (;;) {
        const bool has_next = S.next(ui + 1, nxt);
        const char* nA = has_next ? S.aptr(nxt) : cA; const char* nB = has_next ? S.bptr(nxt) : cB;
        for (int t = 0; t < nt; t += 2) {
            const bool last = (t == nt - 2);
            const char* a1 = cA + (size_t)(t + 1) * kstep;
            const char* a2 = last ? nA : cA + (size_t)(t + 2) * kstep; const char* b2 = last ? nB : cB + (size_t)(t + 2) * kstep;
            const char* a3 = a2 + kstep; const char* b3 = b2 + kstep;
            PG8_LDB(B0, 0, 0); PG8_LDB(B1, 0, 1); PG8_SCHED; PG8_LDA(At, 0, 0); PG8_STAGE(PG8_SA(1, 1), a1 + hstepA, voffA);
            PG8_WAIT_V(8); PG8_WAIT_L(0); PG8_BAR; PG8_MMA(0, 0, At, B0); PG8_MMA(0, 1, At, B1); PG8_BAR; PG8_SCHED;
            PG8_LDA(At, 0, 1); PG8_STAGE(PG8_SB(0, 0), b2, voffB); PG8_STAGE(PG8_SB(0, 1), b2 + hstepB, voffB); PG8_STAGE(PG8_SA(0, 0), a2, voffA);
            PG8_WAIT_V(8); PG8_WAIT_L(0); PG8_BAR; PG8_MMA(1, 0, At, B0); PG8_MMA(1, 1, At, B1); PG8_BAR; PG8_SCHED;
            PG8_LDB(B0, 1, 0); PG8_LDB(B1, 1, 1); PG8_SCHED; PG8_LDA(At, 1, 0); PG8_STAGE(PG8_SA(0, 1), a2 + hstepA, voffA);
            PG8_WAIT_V(8); PG8_WAIT_L(0); PG8_BAR; PG8_MMA(0, 0, At, B0); PG8_MMA(0, 1, At, B1); PG8_BAR; PG8_SCHED;
            PG8_LDA(At, 1, 1); PG8_STAGE(PG8_SB(1, 0), b3, voffB); PG8_STAGE(PG8_SB(1, 1), b3 + hstepB, voffB); PG8_STAGE(PG8_SA(1, 0), a3, voffA);
            PG8_WAIT_V(8); PG8_WAIT_L(0); PG8_BAR; PG8_MMA(1, 0, At, B0); PG8_MMA(1, 1, At, B1); PG8_BAR; PG8_SCHED;
        }
        if (wr == 0) PG8_BAR;
        E(acc, cur, wr, wc, fr, fq);
        if (!has_next) break;
#pragma unroll
        for (int a = 0; a < 2; ++a)
#pragma unroll
            for (int b = 0; b < 2; ++b)
#pragma unroll
                for (int m = 0; m < 4; ++m)
#pragma unroll
                    for (int n = 0; n < 2; ++n) acc[a][b][m][n] = (f32x4){0.f, 0.f, 0.f, 0.f};
        cur = nxt; cA = nA; cB = nB; ++ui;
        if (wr == 1) PG8_BAR;
    }
    PG8_WAIT_V(0);
    PG8_BAR;
#undef PG8_SA
#undef PG8_SB
#undef PG8_STAGE
#undef PG8_LDA
#undef PG8_LDB
#undef PG8_MMA
#undef PG8_WAIT_V
#undef PG8_WAIT_L
#undef PG8_BAR
#undef PG8_SCHED
}
}

struct EpiIn {
    bf16_t* P; const float* qw; const float* kw; const float* rope;
    DI void operator()(const f32x4 (&acc)[2][2][4][2], const pg8::Unit& u, int wr, int wc, int fr, int fq) const {
        const int type = u.pn >> 2;
        const int dlo = 32 * (fq >> 1) + 8 * (fq & 1);
        const int colw = u.pn * 256 + 64 * wc + dlo;
        const bool is_ctx = u.pm >= 128;
        if (type == 2 || type == 3) {
            const float* nw = (type == 2) ? qw : kw;
            const float qs = (type == 2) ? QSCALE : 1.0f;
            f32x4 w[2][2];
#pragma unroll
            for (int bj = 0; bj < 2; ++bj)
#pragma unroll
                for (int n = 0; n < 2; ++n) w[bj][n] = *(const f32x4*)(nw + dlo + 16 * bj + 4 * n);
#pragma unroll
            for (int ai = 0; ai < 2; ++ai)
#pragma unroll
                for (int m = 0; m < 4; ++m) {
                    const int row = u.pm * 256 + ai * 128 + wr * 64 + m * 16 + fr;
                    f32x4 v[2][2]; float ss = 0.f;
#pragma unroll
                    for (int bj = 0; bj < 2; ++bj)
#pragma unroll
                        for (int n = 0; n < 2; ++n) { v[bj][n] = acc[ai][bj][m][n]; const f32x4 q = v[bj][n] * v[bj][n]; ss += (q[0] + q[1]) + (q[2] + q[3]); }
                    ss += swz_xor(ss, 16); ss = sum_x32(ss);
                    const float rinv = rsqrtf(ss * (1.0f / 64.0f) + EPS) * qs;
#pragma unroll
                    for (int bj = 0; bj < 2; ++bj)
#pragma unroll
                        for (int n = 0; n < 2; ++n) v[bj][n] = v[bj][n] * rinv * w[bj][n];
                    if (!is_ctx) {
                        const int t = row & (SEQ - 1), pos = (fq >> 1) ? (t & 63) : (t >> 6);
                        const f32x4* tp = (const f32x4*)(rope + (size_t)(pos * 16 + 8 * (fq & 1)) * 2);
#pragma unroll
                        for (int n = 0; n < 2; ++n) {
                            const f32x4 cs0 = tp[2 * n], cs1 = tp[2 * n + 1];
                            const f32x4 cv = {cs0[0], cs0[2], cs1[0], cs1[2]}, sv = {cs0[1], cs0[3], cs1[1], cs1[3]};
                            const f32x4 x1 = v[0][n], x2 = v[1][n];
                            v[0][n] = x1 * cv - x2 * sv; v[1][n] = x2 * cv + x1 * sv;
                        }
                    }
                    bf16_t* rp = P + (size_t)row * DIN + colw;
#pragma unroll
                    for (int bj = 0; bj < 2; ++bj) { u32x4 o; o.x = cvtpk(v[bj][0][0], v[bj][0][1]); o.y = cvtpk(v[bj][0][2], v[bj][0][3]); o.z = cvtpk(v[bj][1][0], v[bj][1][1]); o.w = cvtpk(v[bj][1][2], v[bj][1][3]);
                        *(u32x4*)(rp + 16 * bj) = o; }
                }
        } else {
            const bool act = (type == 5);
#pragma unroll
            for (int ai = 0; ai < 2; ++ai)
#pragma unroll
                for (int m = 0; m < 4; ++m) {
                    const int row = u.pm * 256 + ai * 128 + wr * 64 + m * 16 + fr;
                    bf16_t* rp = P + (size_t)row * DIN + colw;
#pragma unroll
                    for (int bj = 0; bj < 2; ++bj) { f32x4 x0 = acc[ai][bj][m][0], x1 = acc[ai][bj][m][1];
                        if (act) { x0[0] = silu_f(x0[0]); x0[1] = silu_f(x0[1]); x0[2] = silu_f(x0[2]); x0[3] = silu_f(x0[3]); x1[0] = silu_f(x1[0]); x1[1] = silu_f(x1[1]); x1[2] = silu_f(x1[2]); x1[3] = silu_f(x1[3]); }
                        u32x4 o; o.x = cvtpk(x0[0], x0[1]); o.y = cvtpk(x0[2], x0[3]); o.z = cvtpk(x1[0], x1[1]); o.w = cvtpk(x1[2], x1[3]); *(u32x4*)(rp + 16 * bj) = o; }
                }
        }
    }
};
struct EpiFold {
    bf16_t* WT;
    DI void operator()(const f32x4 (&acc)[2][2][4][2], const pg8::Unit& u, int wr, int wc, int fr, int fq) const {
        const int rbase = (u.pm >> 2) * DIN + (u.pm & 3) * 256 + wr * 64 + fr; const int col0 = u.pn * 256 + wc * 32 + 4 * fq;
#pragma unroll
        for (int ai = 0; ai < 2; ++ai)
#pragma unroll
            for (int m = 0; m < 4; ++m) { bf16_t* rp = WT + (size_t)(rbase + ai * 128 + m * 16) * DM + col0;
#pragma unroll
                for (int bj = 0; bj < 2; ++bj)
#pragma unroll
                    for (int n = 0; n < 2; ++n) { const f32x4 x = acc[ai][bj][m][n]; u32x2 o; o.x = cvtpk(x[0], x[1]); o.y = cvtpk(x[2], x[3]); *(u32x2*)(rp + bj * 128 + n * 16) = o; } }
    }
};
struct EpiOut {
    const float* xin; const bf16_t* xin_b; const float* cin; float* xout; bf16_t* xout_b; float* cout; const float* modl; int layer;
    DI void operator()(const f32x4 (&acc)[2][2][4][2], const pg8::Unit& u, int wr, int wc, int fr, int fq) const {
        const bool is_ctx = u.pm >= 128; const int b = is_ctx ? 8 : (u.pm >> 4);
        const int mode = is_ctx ? 0 : (layer == 0 ? 1 : 2);
        const float* gate = modl + b * DIN + 2 * DM;
        const int row0 = (is_ctx ? (u.pm - 128) : u.pm) * 256 + wr * 64 + fr; const int col0 = u.pn * 256 + wc * 32 + 8 * fq;
        f32x4 gv[2][2];
#pragma unroll
        for (int bj = 0; bj < 2; ++bj)
#pragma unroll
            for (int n = 0; n < 2; ++n) gv[bj][n] = *(const f32x4*)(gate + col0 + bj * 128 + 4 * n);
#pragma unroll
        for (int ai = 0; ai < 2; ++ai)
#pragma unroll
            for (int m = 0; m < 4; ++m) { const size_t off = (size_t)(row0 + ai * 128 + m * 16) * DM + col0;
#pragma unroll
                for (int bj = 0; bj < 2; ++bj) {
                    f32x4 x0, x1;
                    if (mode == 2) { const u32x4 w = *(const u32x4*)(xin_b + off + bj * 128);
                        x0 = (f32x4){bf_lo(w.x), bf_hi(w.x), bf_lo(w.y), bf_hi(w.y)}; x1 = (f32x4){bf_lo(w.z), bf_hi(w.z), bf_lo(w.w), bf_hi(w.w)}; }
                    else { const float* src = is_ctx ? cin : xin; x0 = *(const f32x4*)(src + off + bj * 128); x1 = *(const f32x4*)(src + off + bj * 128 + 4); }
                    const f32x4 y0 = x0 + gv[bj][0] * acc[ai][bj][m][0], y1 = x1 + gv[bj][1] * acc[ai][bj][m][1];
                    if (mode == 1) { u32x4 o; o.x = cvtpk(y0[0], y0[1]); o.y = cvtpk(y0[2], y0[3]); o.z = cvtpk(y1[0], y1[1]); o.w = cvtpk(y1[2], y1[3]); *(u32x4*)(xout_b + off + bj * 128) = o; }
                    else { float* dst = is_ctx ? cout : xout; *(f32x4*)(dst + off + bj * 128) = y0; *(f32x4*)(dst + off + bj * 128 + 4) = y1; }
                }
            }
    }
};
struct FoldOrder {
    const char* pwt; const char* wv; int c;
    DI bool next(int i, pg8::Unit& u) const { if (i != 0 || c >= 64) return false; u.pm = c >> 3; u.pn = c & 7; return true; }
    DI const char* aptr(const pg8::Unit& u) const { return pwt + (size_t)u.pm * 256 * 256 * 2; }
    DI const char* bptr(const pg8::Unit& u) const { return wv + (size_t)(u.pm >> 2) * DM * 1024 * 2 + ((size_t)u.pn * 256 * 1024 + (size_t)(u.pm & 3) * 256) * 2; }
};

DI int perm_row(int N) { return (N & ~255) + 128 * ((N >> 4) & 1) + 32 * ((N >> 6) & 3) + 16 * ((N >> 2) & 1) + 8 * ((N >> 5) & 1) + 4 * ((N >> 3) & 1) + (N & 3); }
DI int perm_row_out(int N) { return (N & ~31) + 16 * ((N >> 2) & 1) + 4 * ((N >> 3) & 3) + (N & 3); }
DI void transpose_tile(const float* src, int ld_src, int k0, int n0, bf16_t* dst, int ld_dst, int perm, LAS float* tile) {
    const int t = threadIdx.x;
    f32x4 v[4][2];
#pragma unroll
    for (int q = 0; q < 4; ++q)
#pragma unroll
        for (int i = 0; i < 2; ++i) { const int r = (t >> 4) + 32 * i, c4 = (t & 15) * 4; v[q][i] = *(const f32x4*)(src + (size_t)(k0 + r) * ld_src + n0 + 64 * q + c4); }
#pragma unroll
    for (int q = 0; q < 4; ++q)
#pragma unroll
        for (int i = 0; i < 2; ++i) { const int r = (t >> 4) + 32 * i, c4 = (t & 15) * 4; LAS float* tp = tile + q * (64 * 65) + r * 65 + c4;
            tp[0] = v[q][i][0]; tp[1] = v[q][i][1]; tp[2] = v[q][i][2]; tp[3] = v[q][i][3]; }
    __syncthreads();
    const int n = t >> 3, k8 = (t & 7) * 8;
#pragma unroll
    for (int q = 0; q < 4; ++q) { const LAS float* s = tile + q * (64 * 65) + k8 * 65 + n;
        u32x4 o; o.x = cvtpk(s[0 * 65], s[1 * 65]); o.y = cvtpk(s[2 * 65], s[3 * 65]); o.z = cvtpk(s[4 * 65], s[5 * 65]); o.w = cvtpk(s[6 * 65], s[7 * 65]);
        const int N = n0 + 64 * q + n, drow = (perm == 1) ? perm_row(N) : ((perm == 2) ? perm_row_out(N) : N);
        *(u32x4*)(dst + (size_t)drow * ld_dst + k0 + k8) = o; }
    __syncthreads();
}
DI void mod_job(const Args& a, int l, int j, LAS float* sc, float* mod) {
    const int t = threadIdx.x, lane = t & 63, wid = t >> 6;
    const float* cc = a.in[1]; const float* cctx = a.in[3];
    for (int idx = t; idx < 9 * DM; idx += NTHREADS) { const int b = idx >> 11, k = idx & (DM - 1); const float v = (b < 8) ? cc[b * DM + k] : cctx[k]; sc[idx] = silu_f(v); }
    __syncthreads();
    const int n0 = 128 * j;
    const float* W = a.in[5] + (size_t)l * DM * DIN + n0 + 2 * lane;
    f32x2 acc[9];
#pragma unroll
    for (int b = 0; b < 9; ++b) acc[b] = (f32x2){0.f, 0.f};
    const int kb = wid * 256;
    for (int k = kb; k < kb + 256; k += 4) {
        f32x2 wv[4];
#pragma unroll
        for (int q = 0; q < 4; ++q) wv[q] = *(const f32x2*)(W + (size_t)(k + q) * DIN);
#pragma unroll
        for (int b = 0; b < 9; ++b) { const f32x4 s = *(const LAS f32x4*)(sc + b * DM + k);
            acc[b] += wv[0] * s[0]; acc[b] += wv[1] * s[1]; acc[b] += wv[2] * s[2]; acc[b] += wv[3] * s[3]; }
    }
    __syncthreads();
#pragma unroll
    for (int b = 0; b < 9; ++b) { sc[(wid * 9 + b) * 128 + 2 * lane] = acc[b][0]; sc[(wid * 9 + b) * 128 + 2 * lane + 1] = acc[b][1]; }
    __syncthreads();
    for (int o = t; o < 9 * 128; o += NTHREADS) { const int b = o >> 7, n = o & 127; float s = 0.f;
#pragma unroll
        for (int w = 0; w < 8; ++w) s += sc[(w * 9 + b) * 128 + n];
        mod[((size_t)l * 9 + b) * DIN + n0 + n] = s + a.in[6][(size_t)l * DIN + n0 + n]; }
    __syncthreads();
}
constexpr int P0_PER_L = 640 + 256 + 16 + 256, P0_NO = 1 + 2 * P0_PER_L;
DI void p0_other(const Args& a, LAS float* lf, int r) {
    const int t = threadIdx.x;
    unsigned char* ws = a.ws;
    bf16_t* WTIN = (bf16_t*)(ws + WS_WTIN); bf16_t* WTOUT = (bf16_t*)(ws + WS_WTOUT); bf16_t* WV = (bf16_t*)(ws + WS_WV); bf16_t* PWT = (bf16_t*)(ws + WS_PWT);
    float* rope = (float*)(ws + WS_ROPE);
    if (r < 1) { for (int e = t; e < 1024; e += NTHREADS) { const int pos = e >> 4, i = e & 15; const float inv = powf(10000.0f, -(float)i / 16.0f); const float ang = (float)pos * inv;
                    rope[2 * e] = cosf(ang); rope[2 * e + 1] = sinf(ang); } return; } r -= 1;
    const int l = r / P0_PER_L; r %= P0_PER_L;
    if (r < 640) { const int kt = r / 20, nt = r % 20; transpose_tile(a.in[7] + (size_t)l * DM * DIN, DIN, kt * 64, 1024 + nt * 256, WTIN + (size_t)l * DIN * DM, DM, 1, lf); return; } r -= 640;
    if (r < 256) { const int kt = r / 8, nt = r % 8; transpose_tile(a.in[17] + (size_t)l * DM * DM, DM, kt * 64, nt * 256, WTOUT + (size_t)l * DM * DM, DM, 2, lf); return; } r -= 256;
    if (r < 16) { const int g = r / 4, kt = r % 4; transpose_tile(a.in[8] + (size_t)(l * 4 + g) * 65536, 256, kt * 64, 0, PWT + (size_t)(l * 4 + g) * 65536, 256, 1, lf); return; } r -= 16;
    {
        const float* src = a.in[7] + (size_t)l * DM * DIN; bf16_t* dst = WV + (size_t)l * DM * 1024;
#pragma unroll
        for (int i = 0; i < 4; ++i) { const int e = (t + NTHREADS * i) * 4, row = 8 * r + (e >> 10), col = e & 1023; const f32x4 v = *(const f32x4*)(src + (size_t)row * DIN + col);
            u32x2 o; o.x = cvtpk(v[0], v[1]); o.y = cvtpk(v[2], v[3]); *(u32x2*)(dst + (size_t)row * 1024 + col) = o; }
    }
}
DI void p0_phase(const Args& a, LAS unsigned char* lds) {
    float* mod = (float*)(a.ws + WS_MOD);
    LAS float* lf = (LAS float*)lds;
    const int G = gridDim.x, b = blockIdx.x;
    constexpr int HI = 3, NH = 96 * HI;
    if (G > 192) {
        if (b < 96) { mod_job(a, b / 48, b % 48, lf, mod); for (int i = 0; i < HI; ++i) p0_other(a, lf, P0_NO - 1 - (b + 96 * i)); }
        else for (int j = b - 96; j < P0_NO - NH; j += G - 96) p0_other(a, lf, j);
    } else {
        for (int job = b; job < 96 + P0_NO; job += G) { if (job < 96) mod_job(a, job / 48, job % 48, lf, mod); else p0_other(a, lf, job - 96); }
    }
}

DI void p1_row(f32x4 (&v)[4][2], const f32x4 (&g)[4][2], const f32x4 (&sh)[4][2], bf16_t* hrow, int lane) {
    float ss = 0.f;
#pragma unroll
    for (int j = 0; j < 4; ++j)
#pragma unroll
        for (int q = 0; q < 2; ++q) { const f32x4 s = v[j][q] * v[j][q]; ss += (s[0] + s[1]) + (s[2] + s[3]); }
    const float rinv = rsqrtf(wave_sum(ss) * (1.0f / DM) + EPS);
#pragma unroll
    for (int j = 0; j < 4; ++j) { const int k = (j * 64 + lane) * 8;
        const f32x4 o0 = v[j][0] * rinv * g[j][0] + sh[j][0], o1 = v[j][1] * rinv * g[j][1] + sh[j][1];
        u32x4 p; p.x = cvtpk(o0[0], o0[1]); p.y = cvtpk(o0[2], o0[3]); p.z = cvtpk(o1[0], o1[1]); p.w = cvtpk(o1[2], o1[3]);
        *(u32x4*)(hrow + k) = p; }
}
DI void p1_mod(f32x4 (&g)[4][2], f32x4 (&sh)[4][2], const float* nw, const float* modl, int b, int lane) {
    const float* shift = modl + b * DIN; const float* scale = shift + DM;
#pragma unroll
    for (int j = 0; j < 4; ++j)
#pragma unroll
        for (int q = 0; q < 2; ++q) { const int k = (j * 64 + lane) * 8 + 4 * q; g[j][q] = *(const f32x4*)(nw + k) * (1.0f + *(const f32x4*)(scale + k)); sh[j][q] = *(const f32x4*)(shift + k); }
}
DI void p1_prep(const float* xin, const bf16_t* xin_b, const float* cin, const float* nw, const float* modl, bf16_t* H) {
    int t = threadIdx.x; asm volatile("" : "+v"(t));
    const int lane = t & 63, wid = t >> 6;
    const int gw = blockIdx.x * 8 + wid, NGW = gridDim.x * 8;
    f32x4 g[4][2], sh[4][2], v[4][2];
    for (int b = 0; b < NB; ++b) {
        if ((gw % NB) != b) continue;
        p1_mod(g, sh, nw, modl, b, lane);
        const int per = NGW / NB;
        for (int r = gw / NB; r < SEQ; r += per) { const int row = b * SEQ + r;
            if (xin_b != nullptr) {
#pragma unroll
                for (int j = 0; j < 4; ++j) { const u32x4 w = *(const u32x4*)(xin_b + (size_t)row * DM + (j * 64 + lane) * 8);
                    v[j][0] = (f32x4){bf_lo(w.x), bf_hi(w.x), bf_lo(w.y), bf_hi(w.y)}; v[j][1] = (f32x4){bf_lo(w.z), bf_hi(w.z), bf_lo(w.w), bf_hi(w.w)}; }
            } else {
#pragma unroll
                for (int j = 0; j < 4; ++j)
#pragma unroll
                    for (int q = 0; q < 2; ++q) v[j][q] = *(const f32x4*)(xin + (size_t)row * DM + (j * 64 + lane) * 8 + 4 * q);
            }
            p1_row(v, g, sh, H + (size_t)row * DM, lane);
        }
    }
    p1_mod(g, sh, nw, modl, 8, lane);
    for (int r = gw; r < MC; r += NGW) {
#pragma unroll
        for (int j = 0; j < 4; ++j)
#pragma unroll
            for (int q = 0; q < 2; ++q) v[j][q] = *(const f32x4*)(cin + (size_t)r * DM + (j * 64 + lane) * 8 + 4 * q);
        p1_row(v, g, sh, H + (size_t)(ML + r) * DM, lane);
    }
}

DI void glds16(const void* gbase, unsigned voff, unsigned lds_dst) {
    unsigned keep;
    asm volatile("s_mov_b32 %0, m0\n\ts_mov_b32 m0, %3\n\ts_nop 0\n\tglobal_load_lds_dwordx4 %1, %2\n\ts_mov_b32 m0, %0" : "=&s"(keep) : "v"(voff), "s"(gbase), "s"(lds_dst) : "memory");
}
DI float fadd_s(float a, float b) { float r; asm("v_add_f32_e32 %0, %1, %2" : "=v"(r) : "v"(a), "v"(b)); return r; }
#define ATT_WAIT_BAR() asm volatile("s_waitcnt vmcnt(0) lgkmcnt(0)\n\ts_barrier" ::: "memory")
DI void attn_unit(LAS unsigned char* lds, const bf16_t* P, bf16_t* Am, int qrow0, int h, int ntiles, int krow_ctx, int krow_lat,
                  float lam, const float* subw, float outscale) {
    int tid = threadIdx.x; asm volatile("" : "+v"(tid));
    const int lane = tid & 63, r32 = lane & 31, hi = lane >> 5;
    const int wid = __builtin_amdgcn_readfirstlane(tid >> 6), g = wid & 3, n = wid >> 2;
    const unsigned lds0 = (unsigned)(uintptr_t)lds;
    const int kkey = 8 * wid + (lane >> 3);
    const unsigned koff = (unsigned)(kkey * DIN + O_K + h * 128 + (((lane & 7) ^ ((kkey >> 1) & 7)) * 8)) * 2u;
    const unsigned voff = (unsigned)(kkey * DIN + O_V + h * 128 + (((lane & 7) ^ (4 * ((lane >> 4) & 1))) * 8)) * 2u;
    const unsigned kdst = lds0 + wid * 1024, vdst = lds0 + 49152 + wid * 1024;
#define ATT_TROW(t) (((t) < 4) ? krow_ctx + 64 * (t) : krow_lat + 64 * ((t) - 4))
#define ATT_DMA_KV(t, buf) do { const bf16_t* base_ = P + (size_t)ATT_TROW(t) * DIN; const unsigned bo_ = (unsigned)(buf) * 16384u; \
        glds16(base_, koff, (unsigned)__builtin_amdgcn_readfirstlane(kdst + bo_)); glds16(base_ + 64, koff, (unsigned)__builtin_amdgcn_readfirstlane(kdst + bo_ + 8192u)); \
        glds16(base_, voff, (unsigned)__builtin_amdgcn_readfirstlane(vdst + bo_)); glds16(base_ + 64, voff, (unsigned)__builtin_amdgcn_readfirstlane(vdst + bo_ + 8192u)); } while (0)
    ATT_DMA_KV(0, 0); ATT_DMA_KV(1, 1);
    bf16x8 qa[4];
    LAS bf16x8* qbl = (LAS bf16x8*)(lds + 98304 + wid * 4096) + lane;
    { const bf16_t* qp = P + (size_t)(qrow0 + 64 * g + r32) * DIN + O_Q + h * 128 + n * 64 + hi * 8;
#pragma unroll
      for (int s = 0; s < 4; ++s) { qa[s] = *(const bf16x8*)(qp + 16 * s); qbl[64 * s] = *(const bf16x8*)(qp + (size_t)32 * DIN + 16 * s); } }
    const unsigned kb_off = n * 8192 + r32 * 128;
    unsigned ksl[4];
#pragma unroll
    for (int s = 0; s < 4; ++s) ksl[s] = (unsigned)(((2 * s + hi) ^ ((r32 >> 1) & 7)) * 16);
    unsigned vb_par[2];
#pragma unroll
    for (int par = 0; par < 2; ++par) { const int q4 = (lane & 15) >> 2, p4 = lane & 3;
        vb_par[par] = 49152 + (4 * hi + q4) * 128 + (4 * (par ^ ((q4 >> 1) & 1)) + 2 * ((lane >> 4) & 1) + (p4 >> 1)) * 16 + (p4 & 1) * 8; }
    f32x16 oa[4], ob[4];
#pragma unroll
    for (int r = 0; r < 16; ++r) { oa[0][r] = 0.f; oa[1][r] = 0.f; oa[2][r] = 0.f; oa[3][r] = 0.f; ob[0][r] = 0.f; ob[1][r] = 0.f; ob[2][r] = 0.f; ob[3][r] = 0.f; }
    float lsa = 0.f, lsb = 0.f;
    ATT_WAIT_BAR();
#define ATT_VTR(p) __builtin_bit_cast(s16x4, __builtin_amdgcn_ds_read_tr16_b64_v4i16((LAS s16x4*)(p)))
#define ATT_QKP(QF, LS, PW) do { \
        _Pragma("unroll") for (int kb = 0; kb < 2; ++kb) {       \
            f32x16 x0; \
            _Pragma("unroll") for (int r = 0; r < 16; ++r) x0[r] = 0.f; \
            _Pragma("unroll") for (int s = 0; s < 4; ++s) x0 = __builtin_amdgcn_mfma_f32_32x32x16_bf16(*(const LAS bf16x8*)(kp + ksl[s] + kb * 4096), QF(s), x0, 0, 0, 0); \
            float ac0 = 0.f, ac1 = 0.f; \
            _Pragma("unroll") for (int r = 0; r < 16; r += 2) { \
                x0[r] = __builtin_amdgcn_exp2f(x0[r]); x0[r + 1] = __builtin_amdgcn_exp2f(x0[r + 1]); \
                ac0 = fadd_s(ac0, x0[r]); ac1 = fadd_s(ac1, x0[r + 1]); } \
            LS += ac0 + ac1; \
            _Pragma("unroll") for (int q = 0; q < 4; ++q) { PW[2 * kb][q] = cvtpk(x0[2 * q], x0[2 * q + 1]); PW[2 * kb + 1][q] = cvtpk(x0[8 + 2 * q], x0[8 + 2 * q + 1]); } \
        } \
    } while (0)
    int s0 = 0, s1 = 1, s2 = 2;
    for (int t = 0; t < ntiles; ++t) {
        const bool more = (t + 2 < ntiles);
        if (more) ATT_DMA_KV(t + 2, s2);
        LAS unsigned char* kp = lds + s0 * 16384 + kb_off;
        LAS unsigned char* vp0 = lds + s0 * 16384 + vb_par[0];
        LAS unsigned char* vp1 = lds + s0 * 16384 + vb_par[1];
        u32x4 pwa[4], pwb[4];
#define ATT_QA(s) qa[s]
#define ATT_QB(s) qbl[64 * (s)]
        ATT_QKP(ATT_QA, lsa, pwa);
        ATT_QKP(ATT_QB, lsb, pwb);
#undef ATT_QA
#undef ATT_QB
        {
            s16x4 vl[2][2], vh[2][2];
#pragma unroll
            for (int i = 0; i < 2; ++i) { LAS unsigned char* vq = (i ? vp1 : vp0); vl[0][i] = ATT_VTR(vq); vh[0][i] = ATT_VTR(vq + 1024); }
#pragma unroll
            for (int gi = 0; gi < 8; ++gi) { const int ks = gi >> 1, dp = gi & 1;
                if (gi < 7) { const int ks2 = (gi + 1) >> 1, dp2 = (gi + 1) & 1;
#pragma unroll
                    for (int i = 0; i < 2; ++i) { LAS unsigned char* vq = (i ? vp1 : vp0) + dp2 * 8192 + ks2 * 2048; vl[(gi + 1) & 1][i] = ATT_VTR(vq); vh[(gi + 1) & 1][i] = ATT_VTR(vq + 1024); } }
                __builtin_amdgcn_sched_barrier(0x406);
#pragma unroll
                for (int i = 0; i < 2; ++i) { const int d0 = 2 * dp + i; const s16x4 lo = vl[gi & 1][i], hh = vh[gi & 1][i];
                    const bf16x8 vf = {lo[0], lo[1], lo[2], lo[3], hh[0], hh[1], hh[2], hh[3]};
                    oa[d0] = __builtin_amdgcn_mfma_f32_32x32x16_bf16(vf, __builtin_bit_cast(bf16x8, pwa[ks]), oa[d0], 0, 0, 0);
                    ob[d0] = __builtin_amdgcn_mfma_f32_32x32x16_bf16(vf, __builtin_bit_cast(bf16x8, pwb[ks]), ob[d0], 0, 0, 0); }
                __builtin_amdgcn_sched_barrier(0x406);
            }
        }
        ATT_WAIT_BAR();
        { const int tmp = s0; s0 = s1; s1 = s2; s2 = tmp; }
    }
#undef ATT_QKP
#undef ATT_DMA_KV
#undef ATT_TROW
#undef ATT_VTR
    lsa = sum_x32(lsa); lsb = sum_x32(lsb);
    const float inva = 1.0f / lsa, invb = 1.0f / lsb;
    int tid2 = threadIdx.x; asm volatile("" : "+v"(tid2));
    const int lane2 = tid2 & 63, r32e = lane2 & 31, hie = lane2 >> 5;
    LAS float* xch = (LAS float*)lds + g * 8192;
    if (n == 1) { const float sa = inva * lam, sb = invb * lam;
#pragma unroll
        for (int d0 = 0; d0 < 4; ++d0)
#pragma unroll
            for (int r = 0; r < 16; ++r) { xch[(d0 * 16 + r) * 64 + lane2] = oa[d0][r] * sa; xch[4096 + (d0 * 16 + r) * 64 + lane2] = ob[d0][r] * sb; } }
    __syncthreads();
    if (n == 0) {
#pragma unroll
        for (int half = 0; half < 2; ++half) {
            float ss = 0.f; const float inv = half ? invb : inva;
#pragma unroll
            for (int d0 = 0; d0 < 4; ++d0)
#pragma unroll
                for (int r = 0; r < 16; ++r) { const float v = (half ? ob[d0][r] : oa[d0][r]) * inv - xch[half * 4096 + (d0 * 16 + r) * 64 + lane2]; if (half) ob[d0][r] = v; else oa[d0][r] = v; ss += v * v; }
            ss = sum_x32(ss);
            const float rr = rsqrtf(ss * (1.0f / 128.0f) + EPS) * outscale;
            LAS float* stg = xch + half * 4096;
#pragma unroll
            for (int d0 = 0; d0 < 4; ++d0)
#pragma unroll
                for (int rg = 0; rg < 4; ++rg) { const int e0 = 32 * d0 + 8 * rg, cc = 8 * d0 + 2 * rg + hie;
                    const f32x4 w4 = *(const f32x4*)(subw + e0 + 4 * hie);
                    const float v0 = half ? ob[d0][4 * rg + 0] : oa[d0][4 * rg + 0], v1 = half ? ob[d0][4 * rg + 1] : oa[d0][4 * rg + 1];
                    const float v2 = half ? ob[d0][4 * rg + 2] : oa[d0][4 * rg + 2], v3 = half ? ob[d0][4 * rg + 3] : oa[d0][4 * rg + 3];
                    const f32x4 tv = {v0 * rr * w4[0], v1 * rr * w4[1], v2 * rr * w4[2], v3 * rr * w4[3]};
                    *(LAS f32x4*)(stg + r32e * 128 + ((cc ^ r32e) & 31) * 4) = tv; }
            const int k16 = lane2 & 15;
#pragma unroll
            for (int i = 0; i < 8; ++i) { const int R = 4 * i + (lane2 >> 4);
                const f32x4 ta = *(const LAS f32x4*)(stg + R * 128 + (((2 * k16) ^ R) & 31) * 4), tb = *(const LAS f32x4*)(stg + R * 128 + (((2 * k16 + 1) ^ R) & 31) * 4);
                const size_t row = (size_t)(qrow0 + 64 * g + 32 * half + R);
                const u32x4 sg = *(const u32x4*)(P + row * DIN + O_AG + h * 128 + 8 * k16);
                u32x4 ov; ov.x = cvtpk(ta[0] * bf_lo(sg.x), ta[1] * bf_hi(sg.x)); ov.y = cvtpk(ta[2] * bf_lo(sg.y), ta[3] * bf_hi(sg.y));
                ov.z = cvtpk(tb[0] * bf_lo(sg.z), tb[1] * bf_hi(sg.z)); ov.w = cvtpk(tb[2] * bf_lo(sg.w), tb[3] * bf_hi(sg.w));
                *(u32x4*)(Am + row * DM + 1024 + h * 128 + 8 * k16) = ov; }
        }
    }
    __syncthreads();
}

template <int GI>
DI void pool_group(const bf16_t* P, bf16_t* Am, const float* pscale, int nrows, int tid) {
    constexpr int HALFW = 1 << GI, W = 2 * HALFW, R = 4, NV = R + W - 1;
    const long total = (long)(nrows / R) * 32;
    for (long idx = (long)blockIdx.x * NTHREADS + tid; idx < total; idx += (long)gridDim.x * NTHREADS) {
        const int row0 = (int)(idx >> 5) * R, c0 = GI * 256 + (int)(idx & 31) * 8;
        int base, tt0, Ls;
        if (row0 < ML) { base = row0 & ~(SEQ - 1); tt0 = row0 & (SEQ - 1); Ls = SEQ; } else { const int r2 = row0 - ML; base = ML + (r2 & ~(CTX - 1)); tt0 = r2 & (CTX - 1); Ls = CTX; }
        u32x4 v[NV];
#pragma unroll
        for (int j = 0; j < NV; ++j) { const int q = min(max(tt0 - HALFW + j, 0), Ls - 1); v[j] = *(const u32x4*)(P + (size_t)(base + q) * DIN + O_PV + c0); }
        u32x4 gv[R];
#pragma unroll
        for (int i = 0; i < R; ++i) gv[i] = *(const u32x4*)(P + (size_t)(row0 + i) * DIN + O_PG + c0);
        const f32x4 p0 = *(const f32x4*)(pscale + c0), p1 = *(const f32x4*)(pscale + c0 + 4);
#pragma unroll
        for (int i = 0; i < R; ++i) {
            float s[8];
#pragma unroll
            for (int e = 0; e < 8; ++e) s[e] = 0.f;
            const int tt = tt0 + i;
#pragma unroll
            for (int j = i; j < i + W; ++j) { const int q = tt0 - HALFW + j; const float m = (q >= 0 && q < Ls) ? 1.0f : 0.0f;
                s[0] += m * bf_lo(v[j].x); s[1] += m * bf_hi(v[j].x); s[2] += m * bf_lo(v[j].y); s[3] += m * bf_hi(v[j].y);
                s[4] += m * bf_lo(v[j].z); s[5] += m * bf_hi(v[j].z); s[6] += m * bf_lo(v[j].w); s[7] += m * bf_hi(v[j].w); }
            const int lo = max(tt - HALFW, 0), hi2 = min(tt + HALFW, Ls);
            const float rc = 1.0f / (float)(hi2 - lo);
            const u32x4 tv = v[i + HALFW], g4 = gv[i];
            float y[8];
            y[0] = (s[0] * rc - bf_lo(tv.x)) * p0[0] * silu_f(bf_lo(g4.x)); y[1] = (s[1] * rc - bf_hi(tv.x)) * p0[1] * silu_f(bf_hi(g4.x));
            y[2] = (s[2] * rc - bf_lo(tv.y)) * p0[2] * silu_f(bf_lo(g4.y)); y[3] = (s[3] * rc - bf_hi(tv.y)) * p0[3] * silu_f(bf_hi(g4.y));
            y[4] = (s[4] * rc - bf_lo(tv.z)) * p1[0] * silu_f(bf_lo(g4.z)); y[5] = (s[5] * rc - bf_hi(tv.z)) * p1[1] * silu_f(bf_hi(g4.z));
            y[6] = (s[6] * rc - bf_lo(tv.w)) * p1[2] * silu_f(bf_lo(g4.w)); y[7] = (s[7] * rc - bf_hi(tv.w)) * p1[3] * silu_f(bf_hi(g4.w));
            u32x4 ov; ov.x = cvtpk(y[0], y[1]); ov.y = cvtpk(y[2], y[3]); ov.z = cvtpk(y[4], y[5]); ov.w = cvtpk(y[6], y[7]);
            *(u32x4*)(Am + (size_t)(row0 + i) * DM + c0) = ov;
        }
    }
}
DI void p3_phase(const Args& a, LAS unsigned char* lds, int l) {
    int tid = threadIdx.x; asm volatile("" : "+v"(tid));
    const int lane = tid & 63;
    unsigned char* ws = a.ws;
    const bf16_t* P = (const bf16_t*)(ws + WS_P); bf16_t* Am = (bf16_t*)(ws + WS_H);
    const float lam_init = (l == 0) ? 0.2f : (0.8f - 0.6f * 0.7408182206817179f);
    const float d1 = wave_sum(a.in[12][l * 64 + lane] * a.in[13][l * 64 + lane]);
    const float d2 = wave_sum(a.in[14][l * 64 + lane] * a.in[15][l * 64 + lane]);
    const float lam = __builtin_bit_cast(float, __builtin_amdgcn_readfirstlane(__builtin_bit_cast(int, expf(d1) - expf(d2) + lam_init)));
    const float outscale = __builtin_bit_cast(float, __builtin_amdgcn_readfirstlane(__builtin_bit_cast(int, 1.0f - lam_init)));
    const float* subw = a.in[16] + l * 128;
    const int G = gridDim.x, c = blockIdx.x;
    const int NU = 1024 + ((l == 0) ? 64 : 0);
    for (int rep_ = 0; rep_ < REP_P3A; ++rep_)
    for (int L = c; L < NU; L += G) {
        int b, h, qrow0, ntl;
        if (L < 1024) { const int j = L >> 3, bh = (L & 7) + 8 * (j >> 4), qb = j & 15; b = bh >> 3; h = bh & 7; qrow0 = b * SEQ + qb * 256; ntl = 68; }
        else { const int e = L - 1024; b = e >> 3; h = e & 7; qrow0 = ML + b * CTX; ntl = 4; }
        attn_unit(lds, P, Am, qrow0, h, ntl, ML + b * CTX, b * SEQ, lam, subw, outscale);
    }
    const float* pscale = a.in[9] + l * 1024;
    const int nrows = (l == 0) ? MT : ML;
    int tid3 = threadIdx.x; asm volatile("" : "+v"(tid3));
    for (int rep_ = 0; rep_ < REP_P3B; ++rep_) {
        pool_group<0>(P, Am, pscale, nrows, tid3); pool_group<1>(P, Am, pscale, nrows, tid3);
        pool_group<2>(P, Am, pscale, nrows, tid3); pool_group<3>(P, Am, pscale, nrows, tid3);
    }
}

#define XB_TMO      128
#define XB_XCNT(j)  (256  + 64 * (j))
#define XB_XSUB(j)  (1280 + 64 * (j))
#define XB_XGEN(j)  (2304 + 64 * (j))
#define XB_TOP      3328
#define XB_TOPGEN   3392
#define XCD_BAR_WORDS 3456
#define XB_SPIN_CAP (1u << 18)

__device__ __forceinline__ unsigned xb_ld(unsigned* p)              { return __hip_atomic_load(p, __ATOMIC_RELAXED, __HIP_MEMORY_SCOPE_AGENT); }
__device__ __forceinline__ unsigned xb_add(unsigned* p, unsigned v) { return __hip_atomic_fetch_add(p, v, __ATOMIC_RELAXED, __HIP_MEMORY_SCOPE_AGENT); }
__device__ __forceinline__ unsigned xb_xcc_id() { return (unsigned)__builtin_amdgcn_s_getreg((3 << 11) | 20) & 0xFu; }
#define XB_SPIN(cond, bar) do { unsigned _sp = 0; while (cond) { __builtin_amdgcn_s_sleep(1); \
    if ((++_sp & 255u) == 0u) { if (xb_ld(&(bar)[XB_TMO])) break; if (_sp > XB_SPIN_CAP) { atomicAdd(&(bar)[XB_TMO], 1u); break; } } } } while (0)

struct XcdBarrier {
    unsigned* bar; unsigned x;
    volatile LAS unsigned* st;
};

__device__ __forceinline__ XcdBarrier xcd_barrier_post(unsigned* bar, volatile LAS unsigned* st) {
    XcdBarrier b; b.bar = bar; b.x = xb_xcc_id(); b.st = st;
    if (threadIdx.x == 0) (void)xb_add(&bar[XB_XCNT(b.x)], 1u);
    return b;
}
__device__ __forceinline__ void xcd_barrier_complete(unsigned* bar, unsigned x, unsigned& nloc, unsigned& nx) {
    const unsigned G = gridDim.x * gridDim.y * gridDim.z;
    unsigned sum, cnt, mine, sp = 0u;
    for (;;) {
        sum = 0u; cnt = 0u; mine = 0u;
#pragma unroll
        for (unsigned j = 0; j < 16; ++j) { const unsigned c = xb_ld(&bar[XB_XCNT(j)]); sum += c; cnt += (c > 0u) ? 1u : 0u; mine = (j == x) ? c : mine; }
        if (sum == G) break;
        __builtin_amdgcn_s_sleep(1);
        if ((++sp & 255u) == 0u) { if (xb_ld(&bar[XB_TMO])) break; if (sp > XB_SPIN_CAP) { atomicAdd(&bar[XB_TMO], 1u); break; } }
    }
    nloc = mine > 0u ? mine : 1u; nx = cnt > 0u ? cnt : 1u;
}

__device__ __forceinline__ void xcd_barrier(const XcdBarrier& b) {
    asm volatile("s_waitcnt vmcnt(0)" ::: "memory");
    __syncthreads();
    if (threadIdx.x == 0) {
        unsigned* bar = b.bar;
        __builtin_amdgcn_s_waitcnt(0);
        unsigned nloc = b.st[0], nx = b.st[1];
        if (nloc == 0u) { xcd_barrier_complete(bar, b.x, nloc, nx); b.st[0] = nloc; b.st[1] = nx; }
        const unsigned old = xb_add(&bar[XB_XSUB(b.x)], 1u);
        const unsigned gen = old / nloc;
        if (old + 1u == (gen + 1u) * nloc) {
            __builtin_amdgcn_fence(__ATOMIC_RELEASE, "agent");
            asm volatile("s_waitcnt vmcnt(0)" ::: "memory");
            const unsigned og = xb_add(&bar[XB_TOP], 1u);
            const unsigned tg = og / nx;
            if (og + 1u == (tg + 1u) * nx) xb_add(&bar[XB_TOPGEN], 1u);
            else XB_SPIN(xb_ld(&bar[XB_TOPGEN]) == tg, bar);
            __builtin_amdgcn_fence(__ATOMIC_ACQUIRE, "agent");
            xb_add(&bar[XB_XGEN(b.x)], 1u);
            asm volatile("s_waitcnt vmcnt(0)" ::: "memory");
        } else {
            XB_SPIN(xb_ld(&bar[XB_XGEN(b.x)]) == gen, bar);
            __builtin_amdgcn_fence(__ATOMIC_ACQUIRE, "agent");
            asm volatile("s_waitcnt vmcnt(0)" ::: "memory");
        }
    }
    __syncthreads();
}


__global__ void __launch_bounds__(NTHREADS, 2) hybrid_fwd(Args a) {
    extern __shared__ __attribute__((aligned(16))) unsigned char lds_raw[];
    LAS unsigned char* lds = (LAS unsigned char*)lds_raw;
    cg::grid_group grid = cg::this_grid();
    unsigned char* ws = a.ws;
    const int G = gridDim.x, c = blockIdx.x;
    bf16_t* WTIN = (bf16_t*)(ws + WS_WTIN); bf16_t* WTOUT = (bf16_t*)(ws + WS_WTOUT);
    bf16_t* H = (bf16_t*)(ws + WS_H); bf16_t* P = (bf16_t*)(ws + WS_P);
    bf16_t* X1b = (bf16_t*)(ws + WS_X1); float* C1 = (float*)(ws + WS_C1);
    const float* mod = (const float*)(ws + WS_MOD); const float* rope = (const float*)(ws + WS_ROPE);

    volatile LAS unsigned* bst = (volatile LAS unsigned*)(lds + 131072);
    if (threadIdx.x == 0) { bst[0] = 0u; bst[1] = 0u; }
    if (blockIdx.x == 0) for (int i = threadIdx.x; i < XCD_BAR_WORDS; i += NTHREADS) ((unsigned*)(ws + WS_CTL))[i] = 0u;
    __syncthreads();
    for (int rep_ = 0; rep_ < REP_P0; ++rep_) p0_phase(a, lds);
    grid.sync();
    const XcdBarrier xbar = xcd_barrier_post((unsigned*)(ws + WS_CTL), bst);
    {
        FoldOrder S{(const char*)(ws + WS_PWT), (const char*)(ws + WS_WV), c};
        EpiFold E{WTIN};
        pg8::gemm_phase<EpiFold, FoldOrder>(lds, pg8::Gemm{256, 1024, 256}, S, E);
    }
    for (int l = 0; l < 2; ++l) {
        const float* xin = a.in[0]; const bf16_t* xin_b = (l == 0) ? (const bf16_t*)nullptr : X1b; const float* cin = (l == 0) ? a.in[2] : C1;
        const float* modl = mod + (size_t)l * 9 * DIN;
        for (int rep_ = 0; rep_ < REP_P1; ++rep_) p1_prep(xin, xin_b, cin, a.in[4] + l * DM, modl, H);
        xcd_barrier(xbar);
        {
            pg8::GridOrder S;
            if (l == 0) S.init(H, WTIN, DM, DM, MT / 256, DIN / 256, G, c);
            else S.init(H, WTIN + (size_t)DIN * DM, DM, DM, ML / 256, DIN / 256, G, c, 64, 128, 8, 12);
            EpiIn E{P, a.in[10] + l * 64, a.in[11] + l * 64, rope};
            for (int rep_ = 0; rep_ < REP_P2; ++rep_) pg8::gemm_phase<EpiIn, pg8::GridOrder>(lds, pg8::Gemm{DM, DM, DM}, S, E);
        }
        xcd_barrier(xbar);
        p3_phase(a, lds, l);
        xcd_barrier(xbar);
        {
            pg8::GridOrder S; S.init(H, WTOUT + (size_t)l * DM * DM, DM, DM, (l == 0 ? MT : ML) / 256, DM / 256, G, c);
            EpiOut E{xin, X1b, cin, a.out, X1b, C1, modl, l};
            for (int rep_ = 0; rep_ < REP_P4; ++rep_) pg8::gemm_phase<EpiOut, pg8::GridOrder>(lds, pg8::Gemm{DM, DM, DM}, S, E);
        }
        if (l == 0) xcd_barrier(xbar);
    }
}

extern "C" void kernel_launch(void* const* d_in, const int* in_sizes, int n_in, void* d_out, int out_size, void* d_ws, size_t ws_size, hipStream_t stream) {
    static int grid = 0;
    if (grid == 0) {
        if (n_in != 18 || in_sizes[0] != ML * DM || out_size != ML * DM || ws_size < WS_END) {
            fprintf(stderr, "kernel_launch: unexpected shapes: n_in %d in0 %d out %d ws %zu (need %zu)\n", n_in, n_in > 0 ? in_sizes[0] : -1, out_size, ws_size, (size_t)WS_END); grid = -1; return; }
        int dev = 0, cus = 0, per_cu = 0;
        hipGetDevice(&dev); hipDeviceGetAttribute(&cus, hipDeviceAttributeMultiprocessorCount, dev);
        if (hipFuncSetAttribute((const void*)hybrid_fwd, hipFuncAttributeMaxDynamicSharedMemorySize, LDS_BYTES) != hipSuccess) { fprintf(stderr, "kernel_launch: hipFuncSetAttribute failed\n"); grid = -1; return; }
        if (hipOccupancyMaxActiveBlocksPerMultiprocessor(&per_cu, (const void*)hybrid_fwd, NTHREADS, LDS_BYTES) != hipSuccess || per_cu < 1) { fprintf(stderr, "kernel_launch: occupancy query gives %d\n", per_cu); per_cu = 1; }
        (void)hipGetLastError();
        grid = cus * per_cu;
    }
    if (grid < 0) return;
    Args a{};
    for (int i = 0; i < 18; ++i) a.in[i] = (const float*)d_in[i];
    a.out = (float*)d_out; a.ws = (unsigned char*)d_ws;
    void* args[] = {&a};
    hipError_t e = hipLaunchCooperativeKernel((const void*)hybrid_fwd, dim3(grid), dim3(NTHREADS), args, LDS_BYTES, stream);
    if (e != hipSuccess) fprintf(stderr, "kernel_launch: cooperative launch failed: %s (grid %d)\n", hipGetErrorString(e), grid);
}
```

```cpp
#include <hip/hip_runtime.h>
#include <hip/hip_cooperative_groups.h>
#include <cstdio>
#include <cstdint>
namespace cg = cooperative_groups;

#define LAS __attribute__((address_space(3)))
#define DI __device__ __forceinline__
typedef unsigned short bf16_t;
typedef short bf16x8 __attribute__((ext_vector_type(8)));
typedef short s16x4 __attribute__((ext_vector_type(4)));
typedef float f32x2 __attribute__((ext_vector_type(2)));
typedef float f32x4 __attribute__((ext_vector_type(4)));
typedef float f32x16 __attribute__((ext_vector_type(16)));
typedef unsigned u32x2 __attribute__((ext_vector_type(2)));
typedef unsigned u32x4 __attribute__((ext_vector_type(4)));
typedef __bf16 bf16x2_t __attribute__((ext_vector_type(2)));

constexpr int NB = 8, SEQ = 4096, DM = 2048, CTX = 256, DIN = 6144, NHEAD = 8;
constexpr int ML = NB * SEQ, MC = NB * CTX, MT = ML + MC;
constexpr int O_PV = 0, O_PG = 1024, O_Q = 2048, O_K = 3072, O_V = 4096, O_AG = 5120;
constexpr float EPS = 1e-6f;
constexpr float QSCALE = 0.125f * 1.4426950408889634f;

constexpr size_t MiB = 1u << 20;
constexpr size_t WS_WTIN = 0;
constexpr size_t WS_WTOUT = 48 * MiB;
constexpr size_t WS_WV = 64 * MiB;
constexpr size_t WS_PWT = 72 * MiB;
constexpr size_t WS_MOD = 73 * MiB;
constexpr size_t WS_ROPE = 74 * MiB;
constexpr size_t WS_CTL = 75 * MiB;
constexpr size_t WS_H = 76 * MiB;
constexpr size_t WS_P = 212 * MiB;
constexpr size_t WS_X1 = 620 * MiB;
constexpr size_t WS_C1 = 876 * MiB;
constexpr size_t WS_END = 892 * MiB;

#ifndef REP_P0
#define REP_P0 1
#endif
#ifndef REP_P1
#define REP_P1 1
#endif
#ifndef REP_P2
#define REP_P2 1
#endif
#ifndef REP_P3A
#define REP_P3A 1
#endif
#ifndef REP_P3B
#define REP_P3B 1
#endif
#ifndef REP_P4
#define REP_P4 1
#endif
constexpr int NTHREADS = 512;
constexpr int LDS_BYTES = 147456;

struct Args { const float* in[18]; float* out; unsigned char* ws; };

DI unsigned cvtpk(float lo, float hi) { f32x2 v = {lo, hi}; bf16x2_t b = __builtin_convertvector(v, bf16x2_t); return __builtin_bit_cast(unsigned, b); }
DI float bf_lo(unsigned u) { return __builtin_bit_cast(float, u << 16); }
DI float bf_hi(unsigned u) { return __builtin_bit_cast(float, u & 0xffff0000u); }
template <int K> DI float swz_xor_t(float v) { return __builtin_bit_cast(float, __builtin_amdgcn_ds_swizzle(__builtin_bit_cast(int, v), (K << 10) | 0x1f)); }
#define swz_xor(v, k) swz_xor_t<(k)>(v)
DI float sum_x32(float v) { const unsigned u = __builtin_bit_cast(unsigned, v); auto rr = __builtin_amdgcn_permlane32_swap(u, u, false, false);
    return __builtin_bit_cast(float, (unsigned)rr[0]) + __builtin_bit_cast(float, (unsigned)rr[1]); }
DI float max_x32(float v) { const unsigned u = __builtin_bit_cast(unsigned, v); auto rr = __builtin_amdgcn_permlane32_swap(u, u, false, false);
    return fmaxf(__builtin_bit_cast(float, (unsigned)rr[0]), __builtin_bit_cast(float, (unsigned)rr[1])); }
DI float wave_sum(float v) { v += swz_xor(v, 1); v += swz_xor(v, 2); v += swz_xor(v, 4); v += swz_xor(v, 8); v += swz_xor(v, 16); return sum_x32(v); }
DI float wave_max(float v) { v = fmaxf(v, swz_xor(v, 1)); v = fmaxf(v, swz_xor(v, 2)); v = fmaxf(v, swz_xor(v, 4)); v = fmaxf(v, swz_xor(v, 8)); v = fmaxf(v, swz_xor(v, 16)); return max_x32(v); }
DI float silu_f(float v) { return v * __builtin_amdgcn_rcpf(1.0f + __expf(-v)); }

namespace pg8 {
constexpr int BM = 256, BK = 64, HALF = 128, HTB = HALF * BK * 2, STAGE_BYTES = 8 * HTB, NXCD = 8, WGM = 8;
DI int lds_byte(int r, int c) { const int st = (r >> 4) * 2 + (c >> 5), rr = r & 15, cc = c & 31, ob = rr * 64 + cc * 2; return st * 1024 + (ob ^ (((ob >> 9) & 1) << 5)); }
DI void stage_rc(int b, int& R, int& C) { const int st = b / 1024, sb = b % 1024, swz = sb ^ (((sb >> 9) & 1) << 5); R = (st >> 1) * 16 + swz / 64; C = (st & 1) * 32 + (swz % 64) / 2; }

struct Unit { int pm, pn; };
struct Gemm { int lda, ldb, K; };

struct GridOrder {
    const char* A; const char* Bt; size_t tstepA, tstepB;
    int nM, nN, nwg, G, c;
    int ex_n, ex_pm0, ex_npm, ex_pn0;
    DI void init(const void* A_, const void* Bt_, int lda, int ldb, int nM_, int nN_, int G_, int c_, int ex_n_ = 0, int ex_pm0_ = 0, int ex_npm_ = 1, int ex_pn0_ = 0) {
        A = (const char*)A_; Bt = (const char*)Bt_; tstepA = (size_t)BM * lda * 2; tstepB = (size_t)BM * ldb * 2;
        nM = nM_; nN = nN_; nwg = nM * nN; G = G_; c = c_; ex_n = ex_n_; ex_pm0 = ex_pm0_; ex_npm = ex_npm_; ex_pn0 = ex_pn0_;
    }
    DI bool next(int i, Unit& u) const {
        const long L = (long)i * G + c;
        if (L >= nwg) { const int e = (int)(L - nwg); if (e >= ex_n) return false; u.pm = ex_pm0 + e % ex_npm; u.pn = ex_pn0 + e / ex_npm; return true; }
        int wgid = (int)L; { const int q = nwg / NXCD, r = nwg % NXCD, xcd = wgid % NXCD, off = wgid / NXCD; wgid = (xcd < r ? xcd * (q + 1) : r * (q + 1) + (xcd - r) * q) + off; }
        const int nig = WGM * nN, gid = wgid / nig, fm = gid * WGM, gsz = (nM - fm) < WGM ? (nM - fm) : WGM;
        u.pm = fm + ((wgid % nig) % gsz); u.pn = (wgid % nig) / gsz; return true;
    }
    DI const char* aptr(const Unit& u) const { return A + (size_t)u.pm * tstepA; }
    DI const char* bptr(const Unit& u) const { return Bt + (size_t)u.pn * tstepB; }
};

template <class Epi, class Sched>
DI void gemm_phase(LAS unsigned char* lds, const Gemm g, const Sched& S, const Epi& E) {
    int tid = threadIdx.x; asm volatile("" : "+v"(tid));
    const int wid = __builtin_amdgcn_readfirstlane(tid >> 6), lane = tid & 63, wr = wid >> 2, wc = wid & 3, fr = lane & 15, fq = lane >> 4;
    const int K = g.K, nt = K / BK;
    unsigned voffA[2], voffB[2];
#pragma unroll
    for (int i = 0; i < 2; ++i) { int R, C; stage_rc(tid * 16 + i * 8192, R, C); voffA[i] = (unsigned)(R * g.lda + C) * 2u; voffB[i] = (unsigned)(R * g.ldb + C) * 2u; }
    const size_t kstep = (size_t)(BK * 2);
    const size_t hstepA = (size_t)HALF * g.lda * 2, hstepB = (size_t)HALF * g.ldb * 2;
    const unsigned ldsw = (unsigned)wid * 1024u;
    const int aoff = lds_byte(wr * 64 + fr, fq * 8), boff = lds_byte(wc * 32 + fr, fq * 8);
#define PG8_SA(b, h) (((b) * 2 + (h)) * HTB)
#define PG8_SB(b, h) ((4 + (b) * 2 + (h)) * HTB)
#define PG8_STAGE(bufoff, gbase, voff) do { _Pragma("unroll") for (int _i = 0; _i < 2; ++_i) \
        __builtin_amdgcn_global_load_lds((const unsigned*)((const char*)(gbase) + (voff)[_i]), (LAS unsigned*)(lds + (bufoff) + ldsw + _i * 8192), 16, 0, 0); } while (0)
#define PG8_LDA(dst, b, h) do { _Pragma("unroll") for (int m = 0; m < 4; ++m) _Pragma("unroll") for (int k = 0; k < 2; ++k) dst[m][k] = *(const LAS bf16x8*)(lds + PG8_SA(b, h) + aoff + m * 2048 + k * 1024); } while (0)
#define PG8_LDB(dst, b, h) do { _Pragma("unroll") for (int n = 0; n < 2; ++n) _Pragma("unroll") for (int k = 0; k < 2; ++k) dst[n][k] = *(const LAS bf16x8*)(lds + PG8_SB(b, h) + boff + n * 2048 + k * 1024); } while (0)
#define PG8_MMA(ai, bj, At, Bt) do { __builtin_amdgcn_s_setprio(1); _Pragma("unroll") for (int m = 0; m < 4; ++m) _Pragma("unroll") for (int n = 0; n < 2; ++n) _Pragma("unroll") for (int k = 0; k < 2; ++k) \
        acc[ai][bj][m][n] = __builtin_amdgcn_mfma_f32_16x16x32_bf16(Bt[n][k], At[m][k], acc[ai][bj][m][n], 0, 0, 0); __builtin_amdgcn_s_setprio(0); } while (0)
#define PG8_WAIT_V(n) asm volatile("s_waitcnt vmcnt(" #n ")" ::: "memory")
#define PG8_WAIT_L(n) asm volatile("s_waitcnt lgkmcnt(" #n ")" ::: "memory")
#define PG8_BAR __builtin_amdgcn_s_barrier()
#define PG8_SCHED __builtin_amdgcn_sched_barrier(0)
    Unit cur, nxt; int ui = 0;
    if (!S.next(0, cur)) return;
    f32x4 acc[2][2][4][2];
#pragma unroll
    for (int a = 0; a < 2; ++a)
#pragma unroll
        for (int b = 0; b < 2; ++b)
#pragma unroll
            for (int m = 0; m < 4; ++m)
#pragma unroll
                for (int n = 0; n < 2; ++n) acc[a][b][m][n] = (f32x4){0.f, 0.f, 0.f, 0.f};
    bf16x8 At[4][2], B0[2][2], B1[2][2];
    const char* cA = S.aptr(cur); const char* cB = S.bptr(cur);
    PG8_STAGE(PG8_SB(0, 0), cB, voffB); PG8_STAGE(PG8_SB(0, 1), cB + hstepB, voffB); PG8_STAGE(PG8_SA(0, 0), cA, voffA); PG8_STAGE(PG8_SA(0, 1), cA + hstepA, voffA);
    if (wr == 1) PG8_BAR;
    PG8_WAIT_V(2); PG8_BAR;
    PG8_STAGE(PG8_SB(1, 0), cB + kstep, voffB); PG8_STAGE(PG8_SA(1, 0), cA + kstep, voffA); PG8_STAGE(PG8_SB(1, 1), cB + hstepB + kstep, voffB);
    PG8_WAIT_V(6); PG8_BAR;
    for (;;) {
        const bool has_next = S.next(ui + 1, nxt);
        const char* nA = has_next ? S.aptr(nxt) : cA; const char* nB = has_next ? S.bptr(nxt) : cB;
        for (int t = 0; t < nt; t += 2) {
            const bool last = (t == nt - 2);
            const char* a1 = cA + (size_t)(t + 1) * kstep;
            const char* a2 = last ? nA : cA + (size_t)(t + 2) * kstep; const char* b2 = last ? nB : cB + (size_t)(t + 2) * kstep;
            const char* a3 = a2 + kstep; const char* b3 = b2 + kstep;
            PG8_LDB(B0, 0, 0); PG8_LDB(B1, 0, 1); PG8_SCHED; PG8_LDA(At, 0, 0); PG8_STAGE(PG8_SA(1, 1), a1 + hstepA, voffA);
            PG8_WAIT_V(8); PG8_WAIT_L(0); PG8_BAR; PG8_MMA(0, 0, At, B0); PG8_MMA(0, 1, At, B1); PG8_BAR; PG8_SCHED;
            PG8_LDA(At, 0, 1); PG8_STAGE(PG8_SB(0, 0), b2, voffB); PG8_STAGE(PG8_SB(0, 1), b2 + hstepB, voffB); PG8_STAGE(PG8_SA(0, 0), a2, voffA);
            PG8_WAIT_V(8); PG8_WAIT_L(0); PG8_BAR; PG8_MMA(1, 0, At, B0); PG8_MMA(1, 1, At, B1); PG8_BAR; PG8_SCHED;
            PG8_LDB(B0, 1, 0); PG8_LDB(B1, 1, 1); PG8_SCHED; PG8_LDA(At, 1, 0); PG8_STAGE(PG8_SA(0, 1), a2 + hstepA, voffA);
            PG8_WAIT_V(8); PG8_WAIT_L(0); PG8_BAR; PG8_MMA(0, 0, At, B0); PG8_MMA(0, 1, At, B1); PG8_BAR; PG8_SCHED;
            PG8_LDA(At, 1, 1); PG8_STAGE(PG8_SB(1, 0), b3, voffB); PG8_STAGE(PG8_SB(1, 1), b3 + hstepB, voffB); PG8_STAGE(PG8_SA(1, 0), a3, voffA);
            PG8_WAIT_V(8); PG8_WAIT_L(0); PG8_BAR; PG8_MMA(1, 0, At, B0); PG8_MMA(1, 1, At, B1); PG8_BAR; PG8_SCHED;
        }
        if (wr == 0) PG8_BAR;
        E(acc, cur, wr, wc, fr, fq);
        if (!has_next) break;
#pragma unroll
        for (int a = 0; a < 2; ++a)
#pragma unroll
            for (int b = 0; b < 2; ++b)
#pragma unroll
                for (int m = 0; m < 4; ++m)
#pragma unroll
                    for (int n = 0; n < 2; ++n) acc[a][b][m][n] = (f32x4){0.f, 0.f, 0.f, 0.f};
        cur = nxt; cA = nA; cB = nB; ++ui;
        if (wr == 1) PG8_BAR;
    }
    PG8_WAIT_V(0);
    PG8_BAR;
#undef PG8_SA
#undef PG8_SB
#undef PG8_STAGE
#undef PG8_LDA
#undef PG8_LDB
#undef PG8_MMA
#undef PG8_WAIT_V
#undef PG8_WAIT_L
#undef PG8_BAR
#undef PG8_SCHED
}
}

struct EpiIn {
    bf16_t* P; const float* qw; const float* kw; const float* rope;
    DI void operator()(const f32x4 (&acc)[2][2][4][2], const pg8::Unit& u, int wr, int wc, int fr, int fq) const {
        const int type = u.pn >> 2;
        const int dlo = 32 * (fq >> 1) + 8 * (fq & 1);
        const int colw = u.pn * 256 + 64 * wc + dlo;
        const bool is_ctx = u.pm >= 128;
        if (type == 2 || type == 3) {
            const float* nw = (type == 2) ? qw : kw;
            const float qs = (type == 2) ? QSCALE : 1.0f;
            f32x4 w[2][2];
#pragma unroll
            for (int bj = 0; bj < 2; ++bj)
#pragma unroll
                for (int n = 0; n < 2; ++n) w[bj][n] = *(const f32x4*)(nw + dlo + 16 * bj + 4 * n);
#pragma unroll
            for (int ai = 0; ai < 2; ++ai)
#pragma unroll
                for (int m = 0; m < 4; ++m) {
                    const int row = u.pm * 256 + ai * 128 + wr * 64 + m * 16 + fr;
                    f32x4 v[2][2]; float ss = 0.f;
#pragma unroll
                    for (int bj = 0; bj < 2; ++bj)
#pragma unroll
                        for (int n = 0; n < 2; ++n) { v[bj][n] = acc[ai][bj][m][n]; const f32x4 q = v[bj][n] * v[bj][n]; ss += (q[0] + q[1]) + (q[2] + q[3]); }
                    ss += swz_xor(ss, 16); ss = sum_x32(ss);
                    const float rinv = rsqrtf(ss * (1.0f / 64.0f) + EPS) * qs;
#pragma unroll
                    for (int bj = 0; bj < 2; ++bj)
#pragma unroll
                        for (int n = 0; n < 2; ++n) v[bj][n] = v[bj][n] * rinv * w[bj][n];
                    if (!is_ctx) {
                        const int t = row & (SEQ - 1), pos = (fq >> 1) ? (t & 63) : (t >> 6);
                        const f32x4* tp = (const f32x4*)(rope + (size_t)(pos * 16 + 8 * (fq & 1)) * 2);
#pragma unroll
                        for (int n = 0; n < 2; ++n) {
                            const f32x4 cs0 = tp[2 * n], cs1 = tp[2 * n + 1];
                            const f32x4 cv = {cs0[0], cs0[2], cs1[0], cs1[2]}, sv = {cs0[1], cs0[3], cs1[1], cs1[3]};
                            const f32x4 x1 = v[0][n], x2 = v[1][n];
                            v[0][n] = x1 * cv - x2 * sv; v[1][n] = x2 * cv + x1 * sv;
                        }
                    }
                    bf16_t* rp = P + (size_t)row * DIN + colw;
#pragma unroll
                    for (int bj = 0; bj < 2; ++bj) { u32x4 o; o.x = cvtpk(v[bj][0][0], v[bj][0][1]); o.y = cvtpk(v[bj][0][2], v[bj][0][3]); o.z = cvtpk(v[bj][1][0], v[bj][1][1]); o.w = cvtpk(v[bj][1][2], v[bj][1][3]);
                        *(u32x4*)(rp + 16 * bj) = o; }
                }
        } else {
            const bool act = (type == 1 || type == 5);
#pragma unroll
            for (int ai = 0; ai < 2; ++ai)
#pragma unroll
                for (int m = 0; m < 4; ++m) {
                    const int row = u.pm * 256 + ai * 128 + wr * 64 + m * 16 + fr;
                    bf16_t* rp = P + (size_t)row * DIN + colw;
#pragma unroll
                    for (int bj = 0; bj < 2; ++bj) { f32x4 x0 = acc[ai][bj][m][0], x1 = acc[ai][bj][m][1];
                        if (act) { x0[0] = silu_f(x0[0]); x0[1] = silu_f(x0[1]); x0[2] = silu_f(x0[2]); x0[3] = silu_f(x0[3]); x1[0] = silu_f(x1[0]); x1[1] = silu_f(x1[1]); x1[2] = silu_f(x1[2]); x1[3] = silu_f(x1[3]); }
                        u32x4 o; o.x = cvtpk(x0[0], x0[1]); o.y = cvtpk(x0[2], x0[3]); o.z = cvtpk(x1[0], x1[1]); o.w = cvtpk(x1[2], x1[3]); *(u32x4*)(rp + 16 * bj) = o; }
                }
        }
    }
};
struct EpiFold {
    bf16_t* WT;
    DI void operator()(const f32x4 (&acc)[2][2][4][2], const pg8::Unit& u, int wr, int wc, int fr, int fq) const {
        const int rbase = (u.pm >> 2) * DIN + (u.pm & 3) * 256 + wr * 64 + fr; const int col0 = u.pn * 256 + wc * 32 + 4 * fq;
#pragma unroll
        for (int ai = 0; ai < 2; ++ai)
#pragma unroll
            for (int m = 0; m < 4; ++m) { bf16_t* rp = WT + (size_t)(rbase + ai * 128 + m * 16) * DM + col0;
#pragma unroll
                for (int bj = 0; bj < 2; ++bj)
#pragma unroll
                    for (int n = 0; n < 2; ++n) { const f32x4 x = acc[ai][bj][m][n]; u32x2 o; o.x = cvtpk(x[0], x[1]); o.y = cvtpk(x[2], x[3]); *(u32x2*)(rp + bj * 128 + n * 16) = o; } }
    }
};
struct EpiOut {
    const float* xin; const bf16_t* xin_b; const float* cin; float* xout; bf16_t* xout_b; float* cout; const float* modl; int layer;
    DI void operator()(const f32x4 (&acc)[2][2][4][2], const pg8::Unit& u, int wr, int wc, int fr, int fq) const {
        const bool is_ctx = u.pm >= 128; const int b = is_ctx ? 8 : (u.pm >> 4);
        const int mode = is_ctx ? 0 : (layer == 0 ? 1 : 2);
        const float* gate = modl + b * DIN + 2 * DM;
        const int row0 = (is_ctx ? (u.pm - 128) : u.pm) * 256 + wr * 64 + fr; const int col0 = u.pn * 256 + wc * 32 + 8 * fq;
        f32x4 gv[2][2];
#pragma unroll
        for (int bj = 0; bj < 2; ++bj)
#pragma unroll
            for (int n = 0; n < 2; ++n) gv[bj][n] = *(const f32x4*)(gate + col0 + bj * 128 + 4 * n);
#pragma unroll
        for (int ai = 0; ai < 2; ++ai)
#pragma unroll
            for (int m = 0; m < 4; ++m) { const size_t off = (size_t)(row0 + ai * 128 + m * 16) * DM + col0;
#pragma unroll
                for (int bj = 0; bj < 2; ++bj) {
                    f32x4 x0, x1;
                    if (mode == 2) { const u32x4 w = *(const u32x4*)(xin_b + off + bj * 128);
                        x0 = (f32x4){bf_lo(w.x), bf_hi(w.x), bf_lo(w.y), bf_hi(w.y)}; x1 = (f32x4){bf_lo(w.z), bf_hi(w.z), bf_lo(w.w), bf_hi(w.w)}; }
                    else { const float* src = is_ctx ? cin : xin; x0 = *(const f32x4*)(src + off + bj * 128); x1 = *(const f32x4*)(src + off + bj * 128 + 4); }
                    const f32x4 y0 = x0 + gv[bj][0] * acc[ai][bj][m][0], y1 = x1 + gv[bj][1] * acc[ai][bj][m][1];
                    if (mode == 1) { u32x4 o; o.x = cvtpk(y0[0], y0[1]); o.y = cvtpk(y0[2], y0[3]); o.z = cvtpk(y1[0], y1[1]); o.w = cvtpk(y1[2], y1[3]); *(u32x4*)(xout_b + off + bj * 128) = o; }
                    else { float* dst = is_ctx ? cout : xout; *(f32x4*)(dst + off + bj * 128) = y0; *(f32x4*)(dst + off + bj * 128 + 4) = y1; }
                }
            }
    }
};
struct FoldOrder {
    const char* pwt; const char* wv; int c;
    DI bool next(int i, pg8::Unit& u) const { if (i != 0 || c >= 64) return false; u.pm = c >> 3; u.pn = c & 7; return true; }
    DI const char* aptr(const pg8::Unit& u) const { return pwt + (size_t)u.pm * 256 * 256 * 2; }
    DI const char* bptr(const pg8::Unit& u) const { return wv + (size_t)(u.pm >> 2) * DM * 1024 * 2 + ((size_t)u.pn * 256 * 1024 + (size_t)(u.pm & 3) * 256) * 2; }
};

DI int perm_row(int N) { return (N & ~255) + 128 * ((N >> 4) & 1) + 32 * ((N >> 6) & 3) + 16 * ((N >> 2) & 1) + 8 * ((N >> 5) & 1) + 4 * ((N >> 3) & 1) + (N & 3); }
DI int perm_row_out(int N) { return (N & ~31) + 16 * ((N >> 2) & 1) + 4 * ((N >> 3) & 3) + (N & 3); }
DI void transpose_tile(const float* src, int ld_src, int k0, int n0, bf16_t* dst, int ld_dst, int perm, LAS float* tile) {
    const int t = threadIdx.x;
    f32x4 v[4][2];
#pragma unroll
    for (int q = 0; q < 4; ++q)
#pragma unroll
        for (int i = 0; i < 2; ++i) { const int r = (t >> 4) + 32 * i, c4 = (t & 15) * 4; v[q][i] = *(const f32x4*)(src + (size_t)(k0 + r) * ld_src + n0 + 64 * q + c4); }
#pragma unroll
    for (int q = 0; q < 4; ++q)
#pragma unroll
        for (int i = 0; i < 2; ++i) { const int r = (t >> 4) + 32 * i, c4 = (t & 15) * 4; LAS float* tp = tile + q * (64 * 65) + r * 65 + c4;
            tp[0] = v[q][i][0]; tp[1] = v[q][i][1]; tp[2] = v[q][i][2]; tp[3] = v[q][i][3]; }
    __syncthreads();
    const int n = t >> 3, k8 = (t & 7) * 8;
#pragma unroll
    for (int q = 0; q < 4; ++q) { const LAS float* s = tile + q * (64 * 65) + k8 * 65 + n;
        u32x4 o; o.x = cvtpk(s[0 * 65], s[1 * 65]); o.y = cvtpk(s[2 * 65], s[3 * 65]); o.z = cvtpk(s[4 * 65], s[5 * 65]); o.w = cvtpk(s[6 * 65], s[7 * 65]);
        const int N = n0 + 64 * q + n, drow = (perm == 1) ? perm_row(N) : ((perm == 2) ? perm_row_out(N) : N);
        *(u32x4*)(dst + (size_t)drow * ld_dst + k0 + k8) = o; }
    __syncthreads();
}
DI void mod_job(const Args& a, int l, int j, LAS float* sc, float* mod) {
    const int t = threadIdx.x, lane = t & 63, wid = t >> 6;
    const float* cc = a.in[1]; const float* cctx = a.in[3];
    for (int idx = t; idx < 9 * DM; idx += NTHREADS) { const int b = idx >> 11, k = idx & (DM - 1); const float v = (b < 8) ? cc[b * DM + k] : cctx[k]; sc[idx] = silu_f(v); }
    __syncthreads();
    const int n0 = 128 * j;
    const float* W = a.in[5] + (size_t)l * DM * DIN + n0 + 2 * lane;
    f32x2 acc[9];
#pragma unroll
    for (int b = 0; b < 9; ++b) acc[b] = (f32x2){0.f, 0.f};
    const int kb = wid * 256;
    for (int k = kb; k < kb + 256; k += 4) {
        f32x2 wv[4];
#pragma unroll
        for (int q = 0; q < 4; ++q) wv[q] = *(const f32x2*)(W + (size_t)(k + q) * DIN);
#pragma unroll
        for (int b = 0; b < 9; ++b) { const f32x4 s = *(const LAS f32x4*)(sc + b * DM + k);
            acc[b] += wv[0] * s[0]; acc[b] += wv[1] * s[1]; acc[b] += wv[2] * s[2]; acc[b] += wv[3] * s[3]; }
    }
    __syncthreads();
#pragma unroll
    for (int b = 0; b < 9; ++b) { sc[(wid * 9 + b) * 128 + 2 * lane] = acc[b][0]; sc[(wid * 9 + b) * 128 + 2 * lane + 1] = acc[b][1]; }
    __syncthreads();
    for (int o = t; o < 9 * 128; o += NTHREADS) { const int b = o >> 7, n = o & 127; float s = 0.f;
#pragma unroll
        for (int w = 0; w < 8; ++w) s += sc[(w * 9 + b) * 128 + n];
        mod[((size_t)l * 9 + b) * DIN + n0 + n] = s + a.in[6][(size_t)l * DIN + n0 + n]; }
    __syncthreads();
}
constexpr int P0_PER_L = 640 + 256 + 16 + 256, P0_NO = 1 + 2 * P0_PER_L;
DI void p0_other(const Args& a, LAS float* lf, int r) {
    const int t = threadIdx.x;
    unsigned char* ws = a.ws;
    bf16_t* WTIN = (bf16_t*)(ws + WS_WTIN); bf16_t* WTOUT = (bf16_t*)(ws + WS_WTOUT); bf16_t* WV = (bf16_t*)(ws + WS_WV); bf16_t* PWT = (bf16_t*)(ws + WS_PWT);
    float* rope = (float*)(ws + WS_ROPE);
    if (r < 1) { for (int e = t; e < 1024; e += NTHREADS) { const int pos = e >> 4, i = e & 15; const float inv = powf(10000.0f, -(float)i / 16.0f); const float ang = (float)pos * inv;
                    rope[2 * e] = cosf(ang); rope[2 * e + 1] = sinf(ang); } return; } r -= 1;
    const int l = r / P0_PER_L; r %= P0_PER_L;
    if (r < 640) { const int kt = r / 20, nt = r % 20; transpose_tile(a.in[7] + (size_t)l * DM * DIN, DIN, kt * 64, 1024 + nt * 256, WTIN + (size_t)l * DIN * DM, DM, 1, lf); return; } r -= 640;
    if (r < 256) { const int kt = r / 8, nt = r % 8; transpose_tile(a.in[17] + (size_t)l * DM * DM, DM, kt * 64, nt * 256, WTOUT + (size_t)l * DM * DM, DM, 2, lf); return; } r -= 256;
    if (r < 16) { const int g = r / 4, kt = r % 4; transpose_tile(a.in[8] + (size_t)(l * 4 + g) * 65536, 256, kt * 64, 0, PWT + (size_t)(l * 4 + g) * 65536, 256, 1, lf); return; } r -= 16;
    {
        const float* src = a.in[7] + (size_t)l * DM * DIN; bf16_t* dst = WV + (size_t)l * DM * 1024;
#pragma unroll
        for (int i = 0; i < 4; ++i) { const int e = (t + NTHREADS * i) * 4, row = 8 * r + (e >> 10), col = e & 1023; const f32x4 v = *(const f32x4*)(src + (size_t)row * DIN + col);
            u32x2 o; o.x = cvtpk(v[0], v[1]); o.y = cvtpk(v[2], v[3]); *(u32x2*)(dst + (size_t)row * 1024 + col) = o; }
    }
}
DI void p0_phase(const Args& a, LAS unsigned char* lds) {
    float* mod = (float*)(a.ws + WS_MOD);
    LAS float* lf = (LAS float*)lds;
    const int G = gridDim.x, b = blockIdx.x;
    constexpr int HI = 3, NH = 96 * HI;
    if (G > 192) {
        if (b < 96) { mod_job(a, b / 48, b % 48, lf, mod); for (int i = 0; i < HI; ++i) p0_other(a, lf, P0_NO - 1 - (b + 96 * i)); }
        else for (int j = b - 96; j < P0_NO - NH; j += G - 96) p0_other(a, lf, j);
    } else {
        for (int job = b; job < 96 + P0_NO; job += G) { if (job < 96) mod_job(a, job / 48, job % 48, lf, mod); else p0_other(a, lf, job - 96); }
    }
}

DI void p1_row(f32x4 (&v)[4][2], const f32x4 (&g)[4][2], const f32x4 (&sh)[4][2], bf16_t* hrow, int lane) {
    float ss = 0.f;
#pragma unroll
    for (int j = 0; j < 4; ++j)
#pragma unroll
        for (int q = 0; q < 2; ++q) { const f32x4 s = v[j][q] * v[j][q]; ss += (s[0] + s[1]) + (s[2] + s[3]); }
    const float rinv = rsqrtf(wave_sum(ss) * (1.0f / DM) + EPS);
#pragma unroll
    for (int j = 0; j < 4; ++j) { const int k = (j * 64 + lane) * 8;
        const f32x4 o0 = v[j][0] * rinv * g[j][0] + sh[j][0], o1 = v[j][1] * rinv * g[j][1] + sh[j][1];
        u32x4 p; p.x = cvtpk(o0[0], o0[1]); p.y = cvtpk(o0[2], o0[3]); p.z = cvtpk(o1[0], o1[1]); p.w = cvtpk(o1[2], o1[3]);
        *(u32x4*)(hrow + k) = p; }
}
DI void p1_mod(f32x4 (&g)[4][2], f32x4 (&sh)[4][2], const float* nw, const float* modl, int b, int lane) {
    const float* shift = modl + b * DIN; const float* scale = shift + DM;
#pragma unroll
    for (int j = 0; j < 4; ++j)
#pragma unroll
        for (int q = 0; q < 2; ++q) { const int k = (j * 64 + lane) * 8 + 4 * q; g[j][q] = *(const f32x4*)(nw + k) * (1.0f + *(const f32x4*)(scale + k)); sh[j][q] = *(const f32x4*)(shift + k); }
}
DI void p1_prep(const float* xin, const bf16_t* xin_b, const float* cin, const float* nw, const float* modl, bf16_t* H) {
    int t = threadIdx.x; asm volatile("" : "+v"(t));
    const int lane = t & 63, wid = t >> 6;
    const int gw = blockIdx.x * 8 + wid, NGW = gridDim.x * 8;
    f32x4 g[4][2], sh[4][2], v[4][2];
    for (int b = 0; b < NB; ++b) {
        if (((int)blockIdx.x % NB) != b) continue;
        p1_mod(g, sh, nw, modl, b, lane);
        const int per = NGW / NB;
        for (int r = ((int)blockIdx.x / NB) * 8 + wid; r < SEQ; r += per) { const int row = b * SEQ + r;
            if (xin_b != nullptr) {
#pragma unroll
                for (int j = 0; j < 4; ++j) { const u32x4 w = *(const u32x4*)(xin_b + (size_t)row * DM + (j * 64 + lane) * 8);
                    v[j][0] = (f32x4){bf_lo(w.x), bf_hi(w.x), bf_lo(w.y), bf_hi(w.y)}; v[j][1] = (f32x4){bf_lo(w.z), bf_hi(w.z), bf_lo(w.w), bf_hi(w.w)}; }
            } else {
#pragma unroll
                for (int j = 0; j < 4; ++j)
#pragma unroll
                    for (int q = 0; q < 2; ++q) v[j][q] = *(const f32x4*)(xin + (size_t)row * DM + (j * 64 + lane) * 8 + 4 * q);
            }
            p1_row(v, g, sh, H + (size_t)row * DM, lane);
        }
    }
    p1_mod(g, sh, nw, modl, 8, lane);
    for (int r = gw; r < MC; r += NGW) {
#pragma unroll
        for (int j = 0; j < 4; ++j)
#pragma unroll
            for (int q = 0; q < 2; ++q) v[j][q] = *(const f32x4*)(cin + (size_t)r * DM + (j * 64 + lane) * 8 + 4 * q);
        p1_row(v, g, sh, H + (size_t)(ML + r) * DM, lane);
    }
}

DI void glds16(const void* gbase, unsigned voff, unsigned lds_dst) {
    unsigned keep;
    asm volatile("s_mov_b32 %0, m0\n\ts_mov_b32 m0, %3\n\ts_nop 0\n\tglobal_load_lds_dwordx4 %1, %2\n\ts_mov_b32 m0, %0" : "=&s"(keep) : "v"(voff), "s"(gbase), "s"(lds_dst) : "memory");
}
DI float fadd_s(float a, float b) { float r; asm("v_add_f32_e32 %0, %1, %2" : "=v"(r) : "v"(a), "v"(b)); return r; }
#define ATT_WAIT_BAR() asm volatile("s_waitcnt vmcnt(0) lgkmcnt(0)\n\ts_barrier" ::: "memory")
DI void attn_unit(LAS unsigned char* lds, const bf16_t* P, bf16_t* Am, int qrow0, int h, int ntiles, int krow_ctx, int krow_lat,
                  float lam, const float* subw, float outscale) {
    int tid = threadIdx.x; asm volatile("" : "+v"(tid));
    const int lane = tid & 63, r32 = lane & 31, hi = lane >> 5;
    const int wid = __builtin_amdgcn_readfirstlane(tid >> 6), g = wid & 3, n = wid >> 2;
    const unsigned lds0 = (unsigned)(uintptr_t)lds;
    const int kkey = 8 * wid + (lane >> 3);
    const unsigned koff = (unsigned)(kkey * DIN + O_K + h * 128 + (((lane & 7) ^ ((kkey >> 1) & 7)) * 8)) * 2u;
    const unsigned voff = (unsigned)(kkey * DIN + O_V + h * 128 + (((lane & 7) ^ (4 * ((lane >> 4) & 1))) * 8)) * 2u;
    const unsigned kdst = lds0 + wid * 1024, vdst = lds0 + 49152 + wid * 1024;
#define ATT_TROW(t) (((t) < 4) ? krow_ctx + 64 * (t) : krow_lat + 64 * ((t) - 4))
#define ATT_DMA_KV(t, buf) do { const bf16_t* base_ = P + (size_t)ATT_TROW(t) * DIN; const unsigned bo_ = (unsigned)(buf) * 16384u; \
        glds16(base_, koff, (unsigned)__builtin_amdgcn_readfirstlane(kdst + bo_)); glds16(base_ + 64, koff, (unsigned)__builtin_amdgcn_readfirstlane(kdst + bo_ + 8192u)); \
        glds16(base_, voff, (unsigned)__builtin_amdgcn_readfirstlane(vdst + bo_)); glds16(base_ + 64, voff, (unsigned)__builtin_amdgcn_readfirstlane(vdst + bo_ + 8192u)); } while (0)
    ATT_DMA_KV(0, 0); ATT_DMA_KV(1, 1);
    bf16x8 qa[4];
    LAS bf16x8* qbl = (LAS bf16x8*)(lds + 98304 + wid * 4096) + lane;
    { const bf16_t* qp = P + (size_t)(qrow0 + 64 * g + r32) * DIN + O_Q + h * 128 + n * 64 + hi * 8;
#pragma unroll
      for (int s = 0; s < 4; ++s) { qa[s] = *(const bf16x8*)(qp + 16 * s); qbl[64 * s] = *(const bf16x8*)(qp + (size_t)32 * DIN + 16 * s); } }
    const unsigned kb_off = n * 8192 + r32 * 128;
    unsigned ksl[4];
#pragma unroll
    for (int s = 0; s < 4; ++s) ksl[s] = (unsigned)(((2 * s + hi) ^ ((r32 >> 1) & 7)) * 16);
    unsigned vb_par[2];
#pragma unroll
    for (int par = 0; par < 2; ++par) { const int q4 = (lane & 15) >> 2, p4 = lane & 3;
        vb_par[par] = 49152 + (4 * hi + q4) * 128 + (4 * (par ^ ((q4 >> 1) & 1)) + 2 * ((lane >> 4) & 1) + (p4 >> 1)) * 16 + (p4 & 1) * 8; }
    f32x16 oa[4], ob[4];
#pragma unroll
    for (int r = 0; r < 16; ++r) { oa[0][r] = 0.f; oa[1][r] = 0.f; oa[2][r] = 0.f; oa[3][r] = 0.f; ob[0][r] = 0.f; ob[1][r] = 0.f; ob[2][r] = 0.f; ob[3][r] = 0.f; }
    float lsa = 0.f, lsb = 0.f;
    ATT_WAIT_BAR();
#define ATT_VTR(p) __builtin_bit_cast(s16x4, __builtin_amdgcn_ds_read_tr16_b64_v4i16((LAS s16x4*)(p)))
#define ATT_QKP(QF, LS, PW) do { \
        _Pragma("unroll") for (int kb = 0; kb < 2; ++kb) {       \
            f32x16 x0; \
            _Pragma("unroll") for (int r = 0; r < 16; ++r) x0[r] = 0.f; \
            _Pragma("unroll") for (int s = 0; s < 4; ++s) x0 = __builtin_amdgcn_mfma_f32_32x32x16_bf16(*(const LAS bf16x8*)(kp + ksl[s] + kb * 4096), QF(s), x0, 0, 0, 0); \
            float ac0 = 0.f, ac1 = 0.f; \
            _Pragma("unroll") for (int r = 0; r < 16; r += 2) { \
                x0[r] = __builtin_amdgcn_exp2f(x0[r]); x0[r + 1] = __builtin_amdgcn_exp2f(x0[r + 1]); \
                ac0 = fadd_s(ac0, x0[r]); ac1 = fadd_s(ac1, x0[r + 1]); } \
            LS += ac0 + ac1; \
            _Pragma("unroll") for (int q = 0; q < 4; ++q) { PW[2 * kb][q] = cvtpk(x0[2 * q], x0[2 * q + 1]); PW[2 * kb + 1][q] = cvtpk(x0[8 + 2 * q], x0[8 + 2 * q + 1]); } \
        } \
    } while (0)
    int s0 = 0, s1 = 1, s2 = 2;
    for (int t = 0; t < ntiles; ++t) {
        const bool more = (t + 2 < ntiles);
        if (more) ATT_DMA_KV(t + 2, s2);
        LAS unsigned char* kp = lds + s0 * 16384 + kb_off;
        LAS unsigned char* vp0 = lds + s0 * 16384 + vb_par[0];
        LAS unsigned char* vp1 = lds + s0 * 16384 + vb_par[1];
        u32x4 pwa[4], pwb[4];
#define ATT_QA(s) qa[s]
#define ATT_QB(s) qbl[64 * (s)]
        ATT_QKP(ATT_QA, lsa, pwa);
        ATT_QKP(ATT_QB, lsb, pwb);
#undef ATT_QA
#undef ATT_QB
        {
            s16x4 vl[2][2], vh[2][2];
#pragma unroll
            for (int i = 0; i < 2; ++i) { LAS unsigned char* vq = (i ? vp1 : vp0); vl[0][i] = ATT_VTR(vq); vh[0][i] = ATT_VTR(vq + 1024); }
#pragma unroll
            for (int gi = 0; gi < 8; ++gi) { const int ks = gi >> 1, dp = gi & 1;
                if (gi < 7) { const int ks2 = (gi + 1) >> 1, dp2 = (gi + 1) & 1;
#pragma unroll
                    for (int i = 0; i < 2; ++i) { LAS unsigned char* vq = (i ? vp1 : vp0) + dp2 * 8192 + ks2 * 2048; vl[(gi + 1) & 1][i] = ATT_VTR(vq); vh[(gi + 1) & 1][i] = ATT_VTR(vq + 1024); } }
                __builtin_amdgcn_sched_barrier(0x406);
#pragma unroll
                for (int i = 0; i < 2; ++i) { const int d0 = 2 * dp + i; const s16x4 lo = vl[gi & 1][i], hh = vh[gi & 1][i];
                    const bf16x8 vf = {lo[0], lo[1], lo[2], lo[3], hh[0], hh[1], hh[2], hh[3]};
                    oa[d0] = __builtin_amdgcn_mfma_f32_32x32x16_bf16(vf, __builtin_bit_cast(bf16x8, pwa[ks]), oa[d0], 0, 0, 0);
                    ob[d0] = __builtin_amdgcn_mfma_f32_32x32x16_bf16(vf, __builtin_bit_cast(bf16x8, pwb[ks]), ob[d0], 0, 0, 0); }
                __builtin_amdgcn_sched_barrier(0x406);
            }
        }
        ATT_WAIT_BAR();
        { const int tmp = s0; s0 = s1; s1 = s2; s2 = tmp; }
    }
#undef ATT_QKP
#undef ATT_DMA_KV
#undef ATT_TROW
#undef ATT_VTR
    lsa = sum_x32(lsa); lsb = sum_x32(lsb);
    const float inva = 1.0f / lsa, invb = 1.0f / lsb;
    int tid2 = threadIdx.x; asm volatile("" : "+v"(tid2));
    const int lane2 = tid2 & 63, r32e = lane2 & 31, hie = lane2 >> 5;
    LAS float* xch = (LAS float*)lds + g * 8192;
    if (n == 1) { const float sa = inva * lam, sb = invb * lam;
#pragma unroll
        for (int d0 = 0; d0 < 4; ++d0)
#pragma unroll
            for (int r = 0; r < 16; ++r) { xch[(d0 * 16 + r) * 64 + lane2] = oa[d0][r] * sa; xch[4096 + (d0 * 16 + r) * 64 + lane2] = ob[d0][r] * sb; } }
    __syncthreads();
    if (n == 0) {
#pragma unroll
        for (int half = 0; half < 2; ++half) {
            float ss = 0.f; const float inv = half ? invb : inva;
#pragma unroll
            for (int d0 = 0; d0 < 4; ++d0)
#pragma unroll
                for (int r = 0; r < 16; ++r) { const float v = (half ? ob[d0][r] : oa[d0][r]) * inv - xch[half * 4096 + (d0 * 16 + r) * 64 + lane2]; if (half) ob[d0][r] = v; else oa[d0][r] = v; ss += v * v; }
            ss = sum_x32(ss);
            const float rr = rsqrtf(ss * (1.0f / 128.0f) + EPS) * outscale;
            LAS float* stg = xch + half * 4096;
#pragma unroll
            for (int d0 = 0; d0 < 4; ++d0)
#pragma unroll
                for (int rg = 0; rg < 4; ++rg) { const int e0 = 32 * d0 + 8 * rg, cc = 8 * d0 + 2 * rg + hie;
                    const f32x4 w4 = *(const f32x4*)(subw + e0 + 4 * hie);
                    const float v0 = half ? ob[d0][4 * rg + 0] : oa[d0][4 * rg + 0], v1 = half ? ob[d0][4 * rg + 1] : oa[d0][4 * rg + 1];
                    const float v2 = half ? ob[d0][4 * rg + 2] : oa[d0][4 * rg + 2], v3 = half ? ob[d0][4 * rg + 3] : oa[d0][4 * rg + 3];
                    const f32x4 tv = {v0 * rr * w4[0], v1 * rr * w4[1], v2 * rr * w4[2], v3 * rr * w4[3]};
                    *(LAS f32x4*)(stg + r32e * 128 + ((cc ^ r32e) & 31) * 4) = tv; }
            const int k16 = lane2 & 15;
#pragma unroll
            for (int i = 0; i < 8; ++i) { const int R = 4 * i + (lane2 >> 4);
                const f32x4 ta = *(const LAS f32x4*)(stg + R * 128 + (((2 * k16) ^ R) & 31) * 4), tb = *(const LAS f32x4*)(stg + R * 128 + (((2 * k16 + 1) ^ R) & 31) * 4);
                const size_t row = (size_t)(qrow0 + 64 * g + 32 * half + R);
                const u32x4 sg = *(const u32x4*)(P + row * DIN + O_AG + h * 128 + 8 * k16);
                u32x4 ov; ov.x = cvtpk(ta[0] * bf_lo(sg.x), ta[1] * bf_hi(sg.x)); ov.y = cvtpk(ta[2] * bf_lo(sg.y), ta[3] * bf_hi(sg.y));
                ov.z = cvtpk(tb[0] * bf_lo(sg.z), tb[1] * bf_hi(sg.z)); ov.w = cvtpk(tb[2] * bf_lo(sg.w), tb[3] * bf_hi(sg.w));
                *(u32x4*)(Am + row * DM + 1024 + h * 128 + 8 * k16) = ov; }
        }
    }
    __syncthreads();
}

template <int GI>
DI void pool_group(const bf16_t* P, bf16_t* Am, const float* pscale, int nrows, int tid) {
    constexpr int HALFW = 1 << GI, W = 2 * HALFW, R = 4, NV = R + W - 1;
    const long total = (long)(nrows / R) * 32;
    for (long idx = (long)blockIdx.x * NTHREADS + tid; idx < total; idx += (long)gridDim.x * NTHREADS) {
        const int row0 = (int)(idx >> 5) * R, c0 = GI * 256 + (int)(idx & 31) * 8;
        int base, tt0, Ls;
        if (row0 < ML) { base = row0 & ~(SEQ - 1); tt0 = row0 & (SEQ - 1); Ls = SEQ; } else { const int r2 = row0 - ML; base = ML + (r2 & ~(CTX - 1)); tt0 = r2 & (CTX - 1); Ls = CTX; }
        u32x4 v[NV];
#pragma unroll
        for (int j = 0; j < NV; ++j) { const int q = min(max(tt0 - HALFW + j, 0), Ls - 1); v[j] = *(const u32x4*)(P + (size_t)(base + q) * DIN + O_PV + c0); }
        u32x4 gv[R];
#pragma unroll
        for (int i = 0; i < R; ++i) gv[i] = *(const u32x4*)(P + (size_t)(row0 + i) * DIN + O_PG + c0);
        const f32x4 p0 = *(const f32x4*)(pscale + c0), p1 = *(const f32x4*)(pscale + c0 + 4);
#pragma unroll
        for (int i = 0; i < R; ++i) {
            float s[8];
#pragma unroll
            for (int e = 0; e < 8; ++e) s[e] = 0.f;
            const int tt = tt0 + i;
#pragma unroll
            for (int j = i; j < i + W; ++j) { const int q = tt0 - HALFW + j; const float m = (q >= 0 && q < Ls) ? 1.0f : 0.0f;
                s[0] += m * bf_lo(v[j].x); s[1] += m * bf_hi(v[j].x); s[2] += m * bf_lo(v[j].y); s[3] += m * bf_hi(v[j].y);
                s[4] += m * bf_lo(v[j].z); s[5] += m * bf_hi(v[j].z); s[6] += m * bf_lo(v[j].w); s[7] += m * bf_hi(v[j].w); }
            const int lo = max(tt - HALFW, 0), hi2 = min(tt + HALFW, Ls);
            const float rc = 1.0f / (float)(hi2 - lo);
            const u32x4 tv = v[i + HALFW], g4 = gv[i];
            float y[8];
            y[0] = (s[0] * rc - bf_lo(tv.x)) * p0[0] * bf_lo(g4.x); y[1] = (s[1] * rc - bf_hi(tv.x)) * p0[1] * bf_hi(g4.x);
            y[2] = (s[2] * rc - bf_lo(tv.y)) * p0[2] * bf_lo(g4.y); y[3] = (s[3] * rc - bf_hi(tv.y)) * p0[3] * bf_hi(g4.y);
            y[4] = (s[4] * rc - bf_lo(tv.z)) * p1[0] * bf_lo(g4.z); y[5] = (s[5] * rc - bf_hi(tv.z)) * p1[1] * bf_hi(g4.z);
            y[6] = (s[6] * rc - bf_lo(tv.w)) * p1[2] * bf_lo(g4.w); y[7] = (s[7] * rc - bf_hi(tv.w)) * p1[3] * bf_hi(g4.w);
            u32x4 ov; ov.x = cvtpk(y[0], y[1]); ov.y = cvtpk(y[2], y[3]); ov.z = cvtpk(y[4], y[5]); ov.w = cvtpk(y[6], y[7]);
            *(u32x4*)(Am + (size_t)(row0 + i) * DM + c0) = ov;
        }
    }
}
DI void p3_phase(const Args& a, LAS unsigned char* lds, int l) {
    int tid = threadIdx.x; asm volatile("" : "+v"(tid));
    const int lane = tid & 63;
    unsigned char* ws = a.ws;
    const bf16_t* P = (const bf16_t*)(ws + WS_P); bf16_t* Am = (bf16_t*)(ws + WS_H);
    const float lam_init = (l == 0) ? 0.2f : (0.8f - 0.6f * 0.7408182206817179f);
    const float d1 = wave_sum(a.in[12][l * 64 + lane] * a.in[13][l * 64 + lane]);
    const float d2 = wave_sum(a.in[14][l * 64 + lane] * a.in[15][l * 64 + lane]);
    const float lam = __builtin_bit_cast(float, __builtin_amdgcn_readfirstlane(__builtin_bit_cast(int, expf(d1) - expf(d2) + lam_init)));
    const float outscale = __builtin_bit_cast(float, __builtin_amdgcn_readfirstlane(__builtin_bit_cast(int, 1.0f - lam_init)));
    const float* subw = a.in[16] + l * 128;
    const int G = gridDim.x, c = blockIdx.x;
    const int NU = 1024 + ((l == 0) ? 64 : 0);
    for (int rep_ = 0; rep_ < REP_P3A; ++rep_)
    for (int L = c; L < NU; L += G) {
        int b, h, qrow0, ntl;
        if (L < 1024) { const int j = L >> 3, bh = (L & 7) + 8 * (j >> 4), qb = j & 15; b = bh >> 3; h = bh & 7; qrow0 = b * SEQ + qb * 256; ntl = 68; }
        else { const int e = L - 1024; b = e >> 3; h = e & 7; qrow0 = ML + b * CTX; ntl = 4; }
        attn_unit(lds, P, Am, qrow0, h, ntl, ML + b * CTX, b * SEQ, lam, subw, outscale);
    }
    const float* pscale = a.in[9] + l * 1024;
    const int nrows = (l == 0) ? MT : ML;
    int tid3 = threadIdx.x; asm volatile("" : "+v"(tid3));
    for (int rep_ = 0; rep_ < REP_P3B; ++rep_) {
        pool_group<0>(P, Am, pscale, nrows, tid3); pool_group<1>(P, Am, pscale, nrows, tid3);
        pool_group<2>(P, Am, pscale, nrows, tid3); pool_group<3>(P, Am, pscale, nrows, tid3);
    }
}

#define XB_TMO      128
#define XB_XCNT(j)  (256  + 64 * (j))
#define XB_XSUB(j)  (1280 + 64 * (j))
#define XB_XGEN(j)  (2304 + 64 * (j))
#define XB_TOP      3328
#define XB_TOPGEN   3392
#define XCD_BAR_WORDS 3456
#define XB_SPIN_CAP (1u << 18)

__device__ __forceinline__ unsigned xb_ld(unsigned* p)              { return __hip_atomic_load(p, __ATOMIC_RELAXED, __HIP_MEMORY_SCOPE_AGENT); }
__device__ __forceinline__ unsigned xb_add(unsigned* p, unsigned v) { return __hip_atomic_fetch_add(p, v, __ATOMIC_RELAXED, __HIP_MEMORY_SCOPE_AGENT); }
__device__ __forceinline__ unsigned xb_xcc_id() { return (unsigned)__builtin_amdgcn_s_getreg((3 << 11) | 20) & 0xFu; }
#define XB_SPIN(cond, bar) do { unsigned _sp = 0; while (cond) { __builtin_amdgcn_s_sleep(1); \
    if ((++_sp & 255u) == 0u) { if (xb_ld(&(bar)[XB_TMO])) break; if (_sp > XB_SPIN_CAP) { atomicAdd(&(bar)[XB_TMO], 1u); break; } } } } while (0)

struct XcdBarrier {
    unsigned* bar; unsigned x;
    volatile LAS unsigned* st;
};

__device__ __forceinline__ XcdBarrier xcd_barrier_post(unsigned* bar, volatile LAS unsigned* st) {
    XcdBarrier b; b.bar = bar; b.x = xb_xcc_id(); b.st = st;
    if (threadIdx.x == 0) (void)xb_add(&bar[XB_XCNT(b.x)], 1u);
    return b;
}
__device__ __forceinline__ void xcd_barrier_complete(unsigned* bar, unsigned x, unsigned& nloc, unsigned& nx) {
    const unsigned G = gridDim.x * gridDim.y * gridDim.z;
    unsigned sum, cnt, mine, sp = 0u;
    for (;;) {
        sum = 0u; cnt = 0u; mine = 0u;
#pragma unroll
        for (unsigned j = 0; j < 16; ++j) { const unsigned c = xb_ld(&bar[XB_XCNT(j)]); sum += c; cnt += (c > 0u) ? 1u : 0u; mine = (j == x) ? c : mine; }
        if (sum == G) break;
        __builtin_amdgcn_s_sleep(1);
        if ((++sp & 255u) == 0u) { if (xb_ld(&bar[XB_TMO])) break; if (sp > XB_SPIN_CAP) { atomicAdd(&bar[XB_TMO], 1u); break; } }
    }
    nloc = mine > 0u ? mine : 1u; nx = cnt > 0u ? cnt : 1u;
}

__device__ __forceinline__ void xcd_barrier(const XcdBarrier& b) {
    asm volatile("s_waitcnt vmcnt(0)" ::: "memory");
    __syncthreads();
    if (threadIdx.x == 0) {
        unsigned* bar = b.bar;
        __builtin_amdgcn_s_waitcnt(0);
        unsigned nloc = b.st[0], nx = b.st[1];
        if (nloc == 0u) { xcd_barrier_complete(bar, b.x, nloc, nx); b.st[0] = nloc; b.st[1] = nx; }
        const unsigned old = xb_add(&bar[XB_XSUB(b.x)], 1u);
        const unsigned gen = old / nloc;
        if (old + 1u == (gen + 1u) * nloc) {
            __builtin_amdgcn_fence(__ATOMIC_RELEASE, "agent");
            asm volatile("s_waitcnt vmcnt(0)" ::: "memory");
            const unsigned og = xb_add(&bar[XB_TOP], 1u);
            const unsigned tg = og / nx;
            if (og + 1u == (tg + 1u) * nx) xb_add(&bar[XB_TOPGEN], 1u);
            else XB_SPIN(xb_ld(&bar[XB_TOPGEN]) == tg, bar);
            __builtin_amdgcn_fence(__ATOMIC_ACQUIRE, "agent");
            xb_add(&bar[XB_XGEN(b.x)], 1u);
            asm volatile("s_waitcnt vmcnt(0)" ::: "memory");
        } else {
            XB_SPIN(xb_ld(&bar[XB_XGEN(b.x)]) == gen, bar);
            __builtin_amdgcn_fence(__ATOMIC_ACQUIRE, "agent");
            asm volatile("s_waitcnt vmcnt(0)" ::: "memory");
        }
    }
    __syncthreads();
}


__global__ void __launch_bounds__(NTHREADS, 2) hybrid_fwd(Args a) {
    extern __shared__ __attribute__((aligned(16))) unsigned char lds_raw[];
    LAS unsigned char* lds = (LAS unsigned char*)lds_raw;
    cg::grid_group grid = cg::this_grid();
    unsigned char* ws = a.ws;
    const int G = gridDim.x, c = blockIdx.x;
    bf16_t* WTIN = (bf16_t*)(ws + WS_WTIN); bf16_t* WTOUT = (bf16_t*)(ws + WS_WTOUT);
    bf16_t* H = (bf16_t*)(ws + WS_H); bf16_t* P = (bf16_t*)(ws + WS_P);
    bf16_t* X1b = (bf16_t*)(ws + WS_X1); float* C1 = (float*)(ws + WS_C1);
    const float* mod = (const float*)(ws + WS_MOD); const float* rope = (const float*)(ws + WS_ROPE);

    volatile LAS unsigned* bst = (volatile LAS unsigned*)(lds + 131072);
    if (threadIdx.x == 0) { bst[0] = 0u; bst[1] = 0u; }
    if (blockIdx.x == 0) for (int i = threadIdx.x; i < XCD_BAR_WORDS; i += NTHREADS) ((unsigned*)(ws + WS_CTL))[i] = 0u;
    __syncthreads();
    for (int rep_ = 0; rep_ < REP_P0; ++rep_) p0_phase(a, lds);
    grid.sync();
    const XcdBarrier xbar = xcd_barrier_post((unsigned*)(ws + WS_CTL), bst);
    {
        FoldOrder S{(const char*)(ws + WS_PWT), (const char*)(ws + WS_WV), c};
        EpiFold E{WTIN};
        pg8::gemm_phase<EpiFold, FoldOrder>(lds, pg8::Gemm{256, 1024, 256}, S, E);
    }
    for (int l = 0; l < 2; ++l) {
        const float* xin = a.in[0]; const bf16_t* xin_b = (l == 0) ? (const bf16_t*)nullptr : X1b; const float* cin = (l == 0) ? a.in[2] : C1;
        const float* modl = mod + (size_t)l * 9 * DIN;
        for (int rep_ = 0; rep_ < REP_P1; ++rep_) p1_prep(xin, xin_b, cin, a.in[4] + l * DM, modl, H);
        xcd_barrier(xbar);
        {
            pg8::GridOrder S;
            if (l == 0) S.init(H, WTIN, DM, DM, MT / 256, DIN / 256, G, c);
            else S.init(H, WTIN + (size_t)DIN * DM, DM, DM, ML / 256, DIN / 256, G, c, 64, 128, 8, 12);
            EpiIn E{P, a.in[10] + l * 64, a.in[11] + l * 64, rope};
            for (int rep_ = 0; rep_ < REP_P2; ++rep_) pg8::gemm_phase<EpiIn, pg8::GridOrder>(lds, pg8::Gemm{DM, DM, DM}, S, E);
        }
        xcd_barrier(xbar);
        p3_phase(a, lds, l);
        xcd_barrier(xbar);
        {
            pg8::GridOrder S; S.init(H, WTOUT + (size_t)l * DM * DM, DM, DM, (l == 0 ? MT : ML) / 256, DM / 256, G, c);
            EpiOut E{xin, X1b, cin, a.out, X1b, C1, modl, l};
            for (int rep_ = 0; rep_ < REP_P4; ++rep_) pg8::gemm_phase<EpiOut, pg8::GridOrder>(lds, pg8::Gemm{DM, DM, DM}, S, E);
        }
        if (l == 0) xcd_barrier(xbar);
    }
}

extern "C" void kernel_launch(void* const* d_in, const int* in_sizes, int n_in, void* d_out, int out_size, void* d_ws, size_t ws_size, hipStream_t stream) {
    static int grid = 0;
    if (grid == 0) {
        if (n_in != 18 || in_sizes[0] != ML * DM || out_size != ML * DM || ws_size < WS_END) {
            fprintf(stderr, "kernel_launch: unexpected shapes: n_in %d in0 %d out %d ws %zu (need %zu)\n", n_in, n_in > 0 ? in_sizes[0] : -1, out_size, ws_size, (size_t)WS_END); grid = -1; return; }
        int dev = 0, cus = 0, per_cu = 0;
        hipGetDevice(&dev); hipDeviceGetAttribute(&cus, hipDeviceAttributeMultiprocessorCount, dev);
        if (hipFuncSetAttribute((const void*)hybrid_fwd, hipFuncAttributeMaxDynamicSharedMemorySize, LDS_BYTES) != hipSuccess) { fprintf(stderr, "kernel_launch: hipFuncSetAttribute failed\n"); grid = -1; return; }
        if (hipOccupancyMaxActiveBlocksPerMultiprocessor(&per_cu, (const void*)hybrid_fwd, NTHREADS, LDS_BYTES) != hipSuccess || per_cu < 1) { fprintf(stderr, "kernel_launch: occupancy query gives %d\n", per_cu); per_cu = 1; }
        (void)hipGetLastError();
        grid = cus * per_cu; grid -= grid % 8;
    }
    if (grid < 0) return;
    Args a{};
    for (int i = 0; i < 18; ++i) a.in[i] = (const float*)d_in[i];
    a.out = (float*)d_out; a.ws = (unsigned char*)d_ws;
    void* args[] = {&a};
    hipError_t e = hipLaunchCooperativeKernel((const void*)hybrid_fwd, dim3(grid), dim3(NTHREADS), args, LDS_BYTES, stream);
    if (e != hipSuccess) fprintf(stderr, "kernel_launch: cooperative launch failed: %s (grid %d)\n", hipGetErrorString(e), grid);
}
```
